# Optimizing an MI355X kernel written in HIP

```python
import math
import jax, jax.numpy as jnp
from jax import lax
import numpy as np

D_MODEL = 1024
BATCH = 16
SEQ = 2048
DEPTH = 4

QBLOCK = 128
NEG_INF = -1e30
FORCE_SCORE = 1e9
RMS_EPS = 1e-6

A_HEADS = 4
A_HEAD_DIM = 64
A_WIDTH = A_HEADS * A_HEAD_DIM
A_KV_LATENT = 128
IDX_HEADS = 8
IDX_DIM = 64
TOPK_MAX = 256

B_HEADS = 4
B_HEAD_DIM = 128
B_WIDTH = B_HEADS * B_HEAD_DIM
CONV_WIDTH = 4
GDN_CHUNK = 64

C_HEADS = 4
C_HEAD_DIM = 64
C_WIDTH = C_HEADS * C_HEAD_DIM
CMP_BLOCK = 32
CMP_STRIDE = 16
SEL_BLOCK = 64
N_SEL = 16
WINDOW = 512
PHI_HIDDEN = 256

N_BUCKETS = 32
BUCKET_MAX_EXACT = 16
BUCKET_MAX_DIST = 128

N_BRANCH = 3
W_MIX = A_WIDTH + B_WIDTH + C_WIDTH

A_COLS = (A_WIDTH, A_KV_LATENT, IDX_HEADS * IDX_DIM, IDX_DIM, IDX_HEADS, A_WIDTH)
B_COLS = (3 * B_WIDTH, B_HEADS, B_HEADS, B_WIDTH)
C_COLS = (C_WIDTH, 6 * C_HEAD_DIM, 3 * C_HEADS, C_WIDTH)
G_COLS = (N_BRANCH * D_MODEL,)
N_IN = sum(A_COLS) + sum(B_COLS) + sum(C_COLS) + sum(G_COLS)

kernel_name = 'hybrid_dsa_gdn_nsa_trunk'


def split_cols(a, sizes):
    idx = np.cumsum(sizes)[:-1].tolist()
    return jnp.split(a, idx, axis=-1)


def split_heads(t, n, d):
    return t.reshape(*t.shape[:-1], n, d)


def rms_norm(x, g):
    x32 = x.astype(jnp.float32)
    y = x32 * lax.rsqrt(jnp.mean(x32 * x32, axis=-1, keepdims=True) + RMS_EPS)
    return (y * g.astype(jnp.float32)).astype(x.dtype)


def l2norm(x):
    x32 = x.astype(jnp.float32)
    return x32 * lax.rsqrt(jnp.sum(x32 * x32, axis=-1, keepdims=True) + RMS_EPS)


def masked_softmax(logits, mask):
    logits = jnp.where(mask, logits.astype(jnp.float32), NEG_INF)
    return jnp.where(mask, jax.nn.softmax(logits, axis=-1), 0.0)


def t5_bucket(dist):
    dist = jnp.maximum(dist, 0)
    log_ratio = jnp.log(jnp.maximum(dist, 1).astype(jnp.float32) / BUCKET_MAX_EXACT) / math.log(BUCKET_MAX_DIST / BUCKET_MAX_EXACT)
    large = BUCKET_MAX_EXACT + (log_ratio * (N_BUCKETS - BUCKET_MAX_EXACT)).astype(jnp.int32)
    large = jnp.minimum(large, N_BUCKETS - 1)
    return jnp.where(dist < BUCKET_MAX_EXACT, dist, large)


def to_qblocks(a):
    b, s = a.shape[:2]
    return jnp.moveaxis(a.reshape(b, s // QBLOCK, QBLOCK, *a.shape[2:]), 1, 0)


def from_qblocks(a):
    nb, b = a.shape[:2]
    return jnp.moveaxis(a, 0, 1).reshape(b, nb * QBLOCK, *a.shape[3:])


def dsa_mixer(q, k, v, q_idx, k_idx, w_idx, bias_tab):
    b, s = q.shape[:2]
    topk = min(TOPK_MAX, s // 4)
    bidx = jnp.arange(b)[:, None, None]
    key_pos = jnp.arange(s)
    scale = A_HEAD_DIM ** -0.5

    def block(args):
        qb, qib, wb, start = args
        t = start + jnp.arange(QBLOCK)
        idx_logits = jnp.einsum('bqhd,bsd->bqhs', qib, k_idx) * (IDX_DIM ** -0.5)
        score = jnp.einsum('bqh,bqhs->bqs', wb * (IDX_HEADS ** -0.5), jax.nn.relu(idx_logits))
        score = jnp.where(key_pos[None, None, :] <= t[None, :, None], score.astype(jnp.float32), NEG_INF)
        _, sel = lax.top_k(score, topk)
        kg = k[bidx, sel]
        vg = v[bidx, sel]
        dist = t[None, :, None] - sel
        bias = jnp.transpose(bias_tab[t5_bucket(dist)], (0, 3, 1, 2))
        logits = jnp.einsum('bqhd,bqkhd->bhqk', qb, kg).astype(jnp.float32) * scale + bias.astype(jnp.float32)
        p = masked_softmax(logits, (dist >= 0)[:, None])
        return jnp.einsum('bhqk,bqkhd->bqhd', p.astype(vg.dtype), vg)

    starts = jnp.arange(s // QBLOCK, dtype=jnp.int32) * QBLOCK
    out = lax.map(block, (to_qblocks(q), to_qblocks(q_idx), to_qblocks(w_idx), starts))
    return from_qblocks(out)


def causal_depthwise_conv(x, w):
    c = x.shape[-1]
    return lax.conv_general_dilated(x, w.astype(x.dtype)[:, None, :], window_strides=(1,), padding=[(CONV_WIDTH - 1, 0)], dimension_numbers=('NWC', 'WIO', 'NWC'), feature_group_count=c)


def gated_deltanet_mixer(qkv, a_in, b_in, conv_w, a_log, dt_bias):
    b, s = qkv.shape[:2]
    n = s // GDN_CHUNK
    qkv = jax.nn.silu(causal_depthwise_conv(qkv, conv_w))
    q, k, v = jnp.split(qkv, 3, axis=-1)
    q = l2norm(split_heads(q, B_HEADS, B_HEAD_DIM)) * (B_HEAD_DIM ** -0.5)
    k = l2norm(split_heads(k, B_HEADS, B_HEAD_DIM))
    v = split_heads(v, B_HEADS, B_HEAD_DIM).astype(jnp.float32)
    beta = jax.nn.sigmoid(b_in.astype(jnp.float32))
    g = -jnp.exp(a_log.astype(jnp.float32)) * jax.nn.softplus(a_in.astype(jnp.float32) + dt_bias.astype(jnp.float32))

    def chunk(t):
        return jnp.moveaxis(t.reshape(b, n, GDN_CHUNK, *t.shape[2:]), 3, 2)

    q, k, v, beta, g = (chunk(t) for t in (q, k, v, beta, g))
    g_cum = jnp.cumsum(g, axis=-1)
    g_last = g_cum[..., -1]
    lower = jnp.tril(jnp.ones((GDN_CHUNK, GDN_CHUNK), dtype=bool))
    strict = jnp.tril(jnp.ones((GDN_CHUNK, GDN_CHUNK), dtype=bool), -1)
    diff = g_cum[..., :, None] - g_cum[..., None, :]
    decay = jnp.where(lower, jnp.exp(jnp.where(lower, diff, 0.0)), 0.0)
    k_beta = k * beta[..., None]
    a_mat = jnp.where(strict, jnp.einsum('bnhid,bnhjd->bnhij', k_beta, k) * decay, 0.0)
    eye = jnp.eye(GDN_CHUNK, dtype=jnp.float32)
    t_inv = lax.linalg.triangular_solve(eye + a_mat, jnp.broadcast_to(eye, a_mat.shape), left_side=True, lower=True)
    u = jnp.einsum('bnhij,bnhjd->bnhid', t_inv, v * beta[..., None])
    w = jnp.einsum('bnhij,bnhjd->bnhid', t_inv, k_beta * jnp.exp(g_cum)[..., None])
    attn = jnp.einsum('bnhid,bnhjd->bnhij', q, k) * decay
    q_dec = q * jnp.exp(g_cum)[..., None]
    k_dec = k * jnp.exp(g_last[..., None] - g_cum)[..., None]

    def step(state, xs):
        u_c, w_c, q_c, k_c, attn_c, gl_c = xs
        v_new = u_c - jnp.einsum('bhik,bhkv->bhiv', w_c, state)
        o = jnp.einsum('bhik,bhkv->bhiv', q_c, state) + jnp.einsum('bhij,bhjv->bhiv', attn_c, v_new)
        state = state * jnp.exp(gl_c)[..., None, None] + jnp.einsum('bhik,bhiv->bhkv', k_c, v_new)
        return state, o

    state0 = jnp.zeros((b, B_HEADS, B_HEAD_DIM, B_HEAD_DIM), jnp.float32)
    xs = tuple(jnp.moveaxis(t, 1, 0) for t in (u, w, q_dec, k_dec, attn, g_last))
    _, o = lax.scan(step, state0, xs)
    o = jnp.moveaxis(jnp.moveaxis(o, 0, 1), 2, 3)
    return o.reshape(b, s, B_HEADS, B_HEAD_DIM)


def compress_blocks(tok, pos, w1, w2):
    b, s, d = tok.shape
    n_cmp = (s - CMP_BLOCK) // CMP_STRIDE + 1
    idx = jnp.arange(n_cmp)[:, None] * CMP_STRIDE + jnp.arange(CMP_BLOCK)[None, :]
    blocks = tok[:, idx] + pos
    return jax.nn.silu(blocks.reshape(b, n_cmp, CMP_BLOCK * d) @ w1) @ w2


def nsa_mixer(q, kv, gates, k_norm, cmp_pos, phi_w1, phi_w2, bias_tab):
    b, s = q.shape[:2]
    scale = C_HEAD_DIM ** -0.5
    t_all = jnp.arange(s)
    k_cmp, v_cmp, k_sel, v_sel, k_win, v_win = (kv[:, :, i] for i in range(6))
    k_sel = rms_norm(k_sel, k_norm[1])
    k_win = rms_norm(k_win, k_norm[2])

    kc = rms_norm(compress_blocks(k_cmp, cmp_pos[0], phi_w1[0], phi_w2[0]), k_norm[0])
    vc = compress_blocks(v_cmp, cmp_pos[1], phi_w1[1], phi_w2[1])
    n_cmp = kc.shape[1]
    cmp_start = jnp.arange(n_cmp) * CMP_STRIDE
    cmp_end = cmp_start + CMP_BLOCK - 1
    cmp_valid = cmp_end[None, :] <= t_all[:, None]
    cmp_bias = jnp.transpose(bias_tab[t5_bucket(t_all[:, None] - cmp_end[None, :])], (2, 0, 1))
    logits = jnp.einsum('bqhd,bnd->bhqn', q, kc).astype(jnp.float32) * scale + cmp_bias.astype(jnp.float32)
    p_cmp = masked_softmax(logits, cmp_valid[None, None])
    o_cmp = jnp.einsum('bhqn,bnd->bqhd', p_cmp.astype(vc.dtype), vc)

    n_sb = s // SEL_BLOCK
    n_pick = min(N_SEL, n_sb)
    sb_start = jnp.arange(n_sb) * SEL_BLOCK
    overlap = ((cmp_start[:, None] < sb_start[None, :] + SEL_BLOCK) & (cmp_start[:, None] + CMP_BLOCK > sb_start[None, :])).astype(jnp.float32)
    importance = jnp.einsum('bhqn,nj->bqj', p_cmp, overlap)
    cur = t_all // SEL_BLOCK
    blk = jnp.arange(n_sb)
    forced = (blk[None, :] == 0) | (blk[None, :] == cur[:, None]) | (blk[None, :] == jnp.maximum(cur[:, None] - 1, 0))
    admissible = sb_start[None, :] <= t_all[:, None]
    importance = jnp.where(admissible[None], jnp.where(forced[None], FORCE_SCORE, importance), NEG_INF)
    _, sel = lax.top_k(importance, n_pick)

    k_blocks = k_sel.reshape(b, n_sb, SEL_BLOCK, C_HEAD_DIM)
    v_blocks = v_sel.reshape(b, n_sb, SEL_BLOCK, C_HEAD_DIM)
    k_win_pad = jnp.pad(k_win, ((0, 0), (WINDOW, 0), (0, 0)))
    v_win_pad = jnp.pad(v_win, ((0, 0), (WINDOW, 0), (0, 0)))
    bidx = jnp.arange(b)[:, None, None]
    n_keys = n_pick * SEL_BLOCK

    def block(args):
        qb, selb, start = args
        t = start + jnp.arange(QBLOCK)
        kg = k_blocks[bidx, selb].reshape(b, QBLOCK, n_keys, C_HEAD_DIM)
        vg = v_blocks[bidx, selb].reshape(b, QBLOCK, n_keys, C_HEAD_DIM)
        s_pos = (selb[..., None] * SEL_BLOCK + jnp.arange(SEL_BLOCK)).reshape(b, QBLOCK, n_keys)
        dist = t[None, :, None] - s_pos
        bias = jnp.transpose(bias_tab[t5_bucket(dist)], (0, 3, 1, 2))
        lg = jnp.einsum('bqhd,bqkd->bhqk', qb, kg).astype(jnp.float32) * scale + bias.astype(jnp.float32)
        p = masked_softmax(lg, (dist >= 0)[:, None])
        o_sel = jnp.einsum('bhqk,bqkd->bqhd', p.astype(vg.dtype), vg)
        kw = lax.dynamic_slice_in_dim(k_win_pad, start, QBLOCK + WINDOW, axis=1)
        vw = lax.dynamic_slice_in_dim(v_win_pad, start, QBLOCK + WINDOW, axis=1)
        s_w = start - WINDOW + jnp.arange(QBLOCK + WINDOW)
        dist_w = t[:, None] - s_w[None, :]
        valid_w = (s_w[None, :] >= 0) & (dist_w >= 0) & (dist_w < WINDOW)
        bias_w = jnp.transpose(bias_tab[t5_bucket(dist_w)], (2, 0, 1))
        lw = jnp.einsum('bqhd,bsd->bhqs', qb, kw).astype(jnp.float32) * scale + bias_w.astype(jnp.float32)
        pw = masked_softmax(lw, valid_w[None, None])
        o_win = jnp.einsum('bhqs,bsd->bqhd', pw.astype(vw.dtype), vw)
        return o_sel, o_win

    starts = jnp.arange(s // QBLOCK, dtype=jnp.int32) * QBLOCK
    o_sel, o_win = lax.map(block, (to_qblocks(q), to_qblocks(sel), starts))
    o_sel = from_qblocks(o_sel)
    o_win = from_qblocks(o_win)
    g = jax.nn.sigmoid(gates.astype(jnp.float32)).reshape(b, s, C_HEADS, 3)
    out = g[..., 0:1] * o_cmp + g[..., 1:2] * o_sel + g[..., 2:3] * o_win
    return out.astype(q.dtype)


def setup_inputs(seed: int = 0) -> dict:
    key = jax.random.key(seed)
    ks = jax.random.split(key, 22)
    f32 = jnp.float32

    def nrm(k, shape, scale):
        return jax.random.normal(k, shape, f32) * scale

    def gain(k, shape):
        return 1.0 + 0.02 * jax.random.normal(k, shape, f32)

    x = nrm(ks[0], (BATCH, SEQ, D_MODEL), 1.0)
    norm_g = gain(ks[1], (DEPTH, D_MODEL))
    w_in = nrm(ks[2], (DEPTH, D_MODEL, N_IN), D_MODEL ** -0.5)
    a_kv_norm = gain(ks[3], (DEPTH, A_KV_LATENT))
    a_w_ukv = nrm(ks[4], (DEPTH, A_KV_LATENT, 2 * A_WIDTH), A_KV_LATENT ** -0.5)
    a_q_norm = gain(ks[5], (DEPTH, A_HEAD_DIM))
    a_k_norm = gain(ks[6], (DEPTH, A_HEAD_DIM))
    b_conv = nrm(ks[7], (DEPTH, CONV_WIDTH, 3 * B_WIDTH), CONV_WIDTH ** -0.5)
    b_a_log = jnp.log(jax.random.uniform(ks[8], (DEPTH, B_HEADS), f32, 1.0, 16.0))
    dt = jnp.exp(jax.random.uniform(ks[9], (DEPTH, B_HEADS), f32, math.log(1e-3), math.log(1e-1)))
    b_dt_bias = dt + jnp.log(-jnp.expm1(-dt))
    b_out_norm = gain(ks[10], (DEPTH, B_HEAD_DIM))
    c_q_norm = gain(ks[11], (DEPTH, C_HEAD_DIM))
    c_k_norm = gain(ks[12], (DEPTH, 3, C_HEAD_DIM))
    c_cmp_pos = nrm(ks[13], (DEPTH, 2, CMP_BLOCK, C_HEAD_DIM), 0.02)
    c_phi_w1 = nrm(ks[14], (DEPTH, 2, CMP_BLOCK * C_HEAD_DIM, PHI_HIDDEN), (CMP_BLOCK * C_HEAD_DIM) ** -0.5)
    c_phi_w2 = nrm(ks[15], (DEPTH, 2, PHI_HIDDEN, C_HEAD_DIM), PHI_HIDDEN ** -0.5)
    w_branch = jnp.concatenate([nrm(ks[16], (DEPTH, A_WIDTH, D_MODEL), A_WIDTH ** -0.5), nrm(ks[17], (DEPTH, B_WIDTH, D_MODEL), B_WIDTH ** -0.5), nrm(ks[18], (DEPTH, C_WIDTH, D_MODEL), C_WIDTH ** -0.5)], axis=1)
    w_out = nrm(ks[19], (DEPTH, D_MODEL, D_MODEL), D_MODEL ** -0.5)
    rel_bias = nrm(ks[20], (N_BUCKETS, A_HEADS + C_HEADS), 0.2)
    return {'x': x, 'norm_g': norm_g, 'w_in': w_in, 'a_kv_norm': a_kv_norm, 'a_w_ukv': a_w_ukv, 'a_q_norm': a_q_norm, 'a_k_norm': a_k_norm, 'b_conv': b_conv, 'b_a_log': b_a_log, 'b_dt_bias': b_dt_bias, 'b_out_norm': b_out_norm, 'c_q_norm': c_q_norm, 'c_k_norm': c_k_norm, 'c_cmp_pos': c_cmp_pos, 'c_phi_w1': c_phi_w1, 'c_phi_w2': c_phi_w2, 'w_branch': w_branch, 'w_out': w_out, 'rel_bias': rel_bias}


def reference(x, norm_g, w_in, a_kv_norm, a_w_ukv, a_q_norm, a_k_norm, b_conv, b_a_log, b_dt_bias, b_out_norm, c_q_norm, c_k_norm, c_cmp_pos, c_phi_w1, c_phi_w2, w_branch, w_out, rel_bias):
    b, s, _ = x.shape
    bias_a = rel_bias[:, :A_HEADS]
    bias_c = rel_bias[:, A_HEADS:]
    for l in range(DEPTH):
        h = rms_norm(x, norm_g[l])
        proj = h @ w_in[l]
        a_part, b_part, c_part, gate_part = split_cols(proj, (sum(A_COLS), sum(B_COLS), sum(C_COLS), sum(G_COLS)))

        a_q, a_ckv, a_qi, a_ki, a_wi, a_z = split_cols(a_part, A_COLS)
        a_k, a_v = jnp.split(rms_norm(a_ckv, a_kv_norm[l]) @ a_w_ukv[l], 2, axis=-1)
        a_q = rms_norm(split_heads(a_q, A_HEADS, A_HEAD_DIM), a_q_norm[l])
        a_k = rms_norm(split_heads(a_k, A_HEADS, A_HEAD_DIM), a_k_norm[l])
        a_v = split_heads(a_v, A_HEADS, A_HEAD_DIM)
        o_a = dsa_mixer(a_q, a_k, a_v, split_heads(a_qi, IDX_HEADS, IDX_DIM), a_ki, a_wi, bias_a)
        y_a = o_a.reshape(b, s, A_WIDTH) * jax.nn.silu(a_z)

        b_qkv, b_a, b_b, b_z = split_cols(b_part, B_COLS)
        o_b = gated_deltanet_mixer(b_qkv, b_a, b_b, b_conv[l], b_a_log[l], b_dt_bias[l])
        y_b = rms_norm(o_b, b_out_norm[l]).reshape(b, s, B_WIDTH).astype(x.dtype) * jax.nn.silu(b_z)

        c_q, c_kv, c_g, c_z = split_cols(c_part, C_COLS)
        c_q = rms_norm(split_heads(c_q, C_HEADS, C_HEAD_DIM), c_q_norm[l])
        o_c = nsa_mixer(c_q, split_heads(c_kv, 6, C_HEAD_DIM), c_g, c_k_norm[l], c_cmp_pos[l], c_phi_w1[l], c_phi_w2[l], bias_c)
        y_c = o_c.reshape(b, s, C_WIDTH) * jax.nn.silu(c_z)

        wb = w_branch[l]
        g_a, g_b, g_c = jnp.split(jax.nn.sigmoid(gate_part), 3, axis=-1)
        merged = g_a * (y_a @ wb[:A_WIDTH]) + g_b * (y_b @ wb[A_WIDTH:A_WIDTH + B_WIDTH]) + g_c * (y_c @ wb[A_WIDTH + B_WIDTH:])
        x = x + (merged @ w_out[l]).astype(x.dtype)
    return x
```

```cpp
#include <hip/hip_runtime.h>
#include <hip/hip_cooperative_groups.h>
#include <cstdio>
namespace cg = cooperative_groups;

typedef unsigned short bf16_t;
using bf16x8 = __attribute__((ext_vector_type(8))) short;
using f32x16 = __attribute__((ext_vector_type(16))) float;
#define DI __device__ __forceinline__
#define MFMA32(a, b, c) __builtin_amdgcn_mfma_f32_32x32x16_bf16((a), (b), (c), 0, 0, 0)

#ifndef PROBE7
#define PROBE7 0
#endif
#ifndef PROBE5
#define PROBE5 0
#endif
#ifndef DUP_MASK
#define DUP_MASK 0
#endif
#ifndef PHASE_ONLY
#define PHASE_ONLY -1
#endif
constexpr int T_TOK = 32768;
constexpr int SEQ = 2048;
constexpr int NPH = 11;
constexpr int B2_S1 = 19, B2_S2 = 23;
constexpr int A1_EARLY = 1152;
constexpr int SMEM_BYTES = 73728;
constexpr int LDA_A = 1664;
constexpr int LDA_B = 1536;
constexpr int LDA_Z = 1024;

struct Params {
  const float* x_in; const float* norm_g; const float* w_in; const float* a_kv_norm; const float* a_w_ukv;
  const float* a_q_norm; const float* a_k_norm; const float* b_conv; const float* b_a_log; const float* b_dt_bias;
  const float* b_out_norm; const float* c_q_norm; const float* c_k_norm; const float* c_cmp_pos;
  const float* c_phi_w1; const float* c_phi_w2; const float* w_branch; const float* w_out; const float* rel_bias;
  float* out;
  bf16_t* wt_in; bf16_t* wt_ukv; bf16_t* wt_phi1; bf16_t* wt_phi2; bf16_t* wt_br; bf16_t* wt_out;
  float* posbias;
  bf16_t* h; bf16_t* projA; bf16_t* projB; bf16_t* projZ; float* small;
  bf16_t* akv; bf16_t* avT; bf16_t* vselT; bf16_t* vwinT; bf16_t* hid; bf16_t* kc; bf16_t* vcT; bf16_t* kselF; bf16_t* kwinF; bf16_t* kidxF;
  unsigned* bm; unsigned* selmask;
  float* b_state; bf16_t* b_w; bf16_t* b_qd; bf16_t* b_kdT; bf16_t* b_attn; bf16_t* b_uT; float* b_egl;
  bf16_t* ob; bf16_t* merged;
};

DI int tid_launder() { int t = threadIdx.x; asm volatile("" : "+v"(t)); return t; }
#define TIDX (tid_launder())
DI float bf2f(bf16_t b) { return __uint_as_float(((unsigned)b) << 16); }
typedef __bf16 hwbf2 __attribute__((ext_vector_type(2)));
typedef float hwf2 __attribute__((ext_vector_type(2)));
DI unsigned pack2(float a, float b) { hwf2 v = {a, b}; hwbf2 r = __builtin_convertvector(v, hwbf2); return __builtin_bit_cast(unsigned, r); }
DI bf16_t f2bf(float x) { return (bf16_t)(pack2(x, 0.f) & 0xffffu); }
DI int crow(int reg, int hh) { return (reg & 3) + 8 * (reg >> 2) + 4 * hh; }
DI float siluf(float x) { return x * __builtin_amdgcn_rcpf(1.f + __expf(-x)); }
DI float sigmoidf(float x) { return __builtin_amdgcn_rcpf(1.f + __expf(-x)); }
DI float wave_sum(float v) {
#pragma unroll
  for (int o = 32; o >= 1; o >>= 1) v += __shfl_xor(v, o);
  return v;
}
DI bf16x8 pack8(const f32x16& x, int s) {
  uint4 u;
  u.x = pack2(x[8 * s + 0], x[8 * s + 1]); u.y = pack2(x[8 * s + 2], x[8 * s + 3]);
  u.z = pack2(x[8 * s + 4], x[8 * s + 5]); u.w = pack2(x[8 * s + 6], x[8 * s + 7]);
  return __builtin_bit_cast(bf16x8, u);
}
DI bf16x8 ld_perm(const bf16_t* p, int hh) {
  uint2 lo = *(const uint2*)(p + 4 * hh);
  uint2 hi = *(const uint2*)(p + 8 + 4 * hh);
  uint4 u; u.x = lo.x; u.y = lo.y; u.z = hi.x; u.w = hi.y;
  return __builtin_bit_cast(bf16x8, u);
}
DI int foff_nat(int r, int k) { return (((k >> 4) * 2 + ((k >> 3) & 1)) * 32 + r) * 8 + (k & 7); }
DI int foff_perm(int r, int k) { const int kk = k & 15; return (((k >> 4) * 2 + ((kk >> 2) & 1)) * 32 + r) * 8 + (((kk >> 3) << 2) | (kk & 3)); }
DI bf16x8 ld16(const bf16_t* p) { return __builtin_bit_cast(bf16x8, *(const uint4*)p); }

DI int srccol(int j) {
  if (j < 256) return j;
  if (j < 512) return 3280 + (j - 256);
  if (j < 640) return 256 + (j - 512);
  if (j < 1152) return 384 + (j - 640);
  if (j < 1216) return 896 + (j - 1152);
  if (j < 1280) return 3536 + (j - 1216);
  if (j < 1344) return 3600 + (j - 1280);
  if (j < 1408) return 3664 + (j - 1344);
  if (j < 1472) return 3792 + (j - 1408);
  if (j < 1536) return 3728 + (j - 1472);
  if (j < 1600) return 3856 + (j - 1536);
  if (j < 1608) return 960 + (j - 1600);
  if (j < 1612) return 2760 + (j - 1608);
  if (j < 1616) return 2764 + (j - 1612);
  if (j < 1628) return 3920 + (j - 1616);
  if (j < 1664) return -1;
  if (j < 3200) return 1224 + (j - 1664);
  if (j < 3456) return 968 + (j - 3200);
  if (j < 3968) return 2768 + (j - 3456);
  if (j < 4224) return 3932 + (j - 3968);
  return 4188 + (j - 4224);
}

DI void tr_job(const float* __restrict__ src, int ld, int K, int Nsrc, bool map, bf16_t* __restrict__ dst, int Nrows,
               float* lds, int rot) {
  const int ntk = K / 64, ntiles = (Nrows / 64) * ntk;
  const int vb = (blockIdx.x + rot) % gridDim.x;
  const int tx = TIDX & 63, ty = TIDX >> 6;
  for (int t = vb; t < ntiles; t += gridDim.x) {
    const int j0 = (t / ntk) * 64, k0 = (t % ntk) * 64;
    const int j = j0 + tx;
    const int sc = map ? srccol(j) : (j < Nsrc ? j : -1);
    {
      float v[16];
      const int scc = sc >= 0 ? sc : 0;
#pragma unroll
      for (int q = 0; q < 16; ++q) v[q] = src[(size_t)(k0 + ty + 4 * q) * ld + scc];
#pragma unroll
      for (int q = 0; q < 16; ++q) lds[(ty + 4 * q) * 65 + tx] = sc >= 0 ? v[q] : 0.f;
    }
    __syncthreads();
    for (int jj = ty; jj < 64; jj += 4) dst[(size_t)(j0 + jj) * K + k0 + tx] = f2bf(lds[tx * 65 + jj]);
    __syncthreads();
  }
}

DI void phase0(const Params& p, int l, char* smem) {
  float* lds = (float*)smem;
  tr_job(p.w_in + (size_t)l * 1024 * 7260, 7260, 1024, 7260, true, p.wt_in, 7296, lds, 0);
  tr_job(p.a_w_ukv + (size_t)l * 128 * 512, 512, 128, 512, false, p.wt_ukv, 512, lds, 64);
  for (int kv = 0; kv < 2; ++kv) {
    tr_job(p.c_phi_w1 + ((size_t)l * 2 + kv) * 2048 * 256, 256, 2048, 256, false, p.wt_phi1 + (size_t)kv * 256 * 2048, 256, lds, 96 + kv * 128);
    tr_job(p.c_phi_w2 + ((size_t)l * 2 + kv) * 256 * 64, 64, 256, 64, false, p.wt_phi2 + (size_t)kv * 128 * 256, 128, lds, 80 + kv * 8);
  }
  tr_job(p.w_branch + (size_t)l * 1024 * 1024, 1024, 1024, 1024, false, p.wt_br, 1024, lds, 352);
  tr_job(p.w_out + (size_t)l * 1024 * 1024, 1024, 1024, 1024, false, p.wt_out, 1024, lds, 96);
  {
    const int vb = (blockIdx.x + 200) % gridDim.x;
    for (int j = vb; j < 16; j += gridDim.x) {
      const int kv = j >> 3, n = (j & 7) * 32 + (TIDX & 31), kg = TIDX >> 5;
      const float* pos = p.c_cmp_pos + ((size_t)l * 2 + kv) * 2048;
      const float* w1 = p.c_phi_w1 + ((size_t)l * 2 + kv) * 2048 * 256;
      float s = 0.f;
      for (int kk0 = kg * 256; kk0 < kg * 256 + 256; kk0 += 32) {
        float pv[32], wv[32];
#pragma unroll
        for (int j2 = 0; j2 < 32; ++j2) { pv[j2] = pos[kk0 + j2]; wv[j2] = w1[(size_t)(kk0 + j2) * 256 + n]; }
#pragma unroll
        for (int j2 = 0; j2 < 32; ++j2) s += pv[j2] * wv[j2];
      }
      lds[TIDX] = s;
      __syncthreads();
      if (TIDX < 32) {
        float tsum = 0.f;
        for (int g = 0; g < 8; ++g) tsum += lds[g * 32 + TIDX];
        p.posbias[kv * 256 + n] = tsum;
      }
      __syncthreads();
    }
  }
  {
    const float* x = l == 0 ? p.x_in : p.out;
    const float* g = p.norm_g + (size_t)l * 1024;
    const int lane = TIDX & 63, wave = TIDX >> 6;
    float4 gg[4];
#pragma unroll
    for (int i = 0; i < 4; ++i) gg[i] = ((const float4*)g)[lane + 64 * i];
    const int tstep = gridDim.x * 4;
    int t = blockIdx.x * 4 + wave;
    float4 v0, v1, v2, v3;
    if (t < T_TOK) { const float4* xr = (const float4*)(x + (size_t)t * 1024); v0 = xr[lane]; v1 = xr[lane + 64]; v2 = xr[lane + 128]; v3 = xr[lane + 192]; }
#pragma unroll 1
    for (; t < T_TOK; t += tstep) {
      const float4 c0 = v0, c1 = v1, c2 = v2, c3 = v3;
      const int tn = t + tstep < T_TOK ? t + tstep : t;
      { const float4* xr = (const float4*)(x + (size_t)tn * 1024); v0 = xr[lane]; v1 = xr[lane + 64]; v2 = xr[lane + 128]; v3 = xr[lane + 192]; }
      float ss = c0.x * c0.x + c0.y * c0.y + c0.z * c0.z + c0.w * c0.w + c1.x * c1.x + c1.y * c1.y + c1.z * c1.z + c1.w * c1.w
               + c2.x * c2.x + c2.y * c2.y + c2.z * c2.z + c2.w * c2.w + c3.x * c3.x + c3.y * c3.y + c3.z * c3.z + c3.w * c3.w;
      ss = wave_sum(ss);
      const float r = rsqrtf(ss * (1.f / 1024.f) + 1e-6f);
      bf16_t* hr = p.h + (size_t)t * 1024 + lane * 4;
      uint2 o;
      o.x = pack2(c0.x * r * gg[0].x, c0.y * r * gg[0].y); o.y = pack2(c0.z * r * gg[0].z, c0.w * r * gg[0].w); *(uint2*)(hr) = o;
      o.x = pack2(c1.x * r * gg[1].x, c1.y * r * gg[1].y); o.y = pack2(c1.z * r * gg[1].z, c1.w * r * gg[1].w); *(uint2*)(hr + 256) = o;
      o.x = pack2(c2.x * r * gg[2].x, c2.y * r * gg[2].y); o.y = pack2(c2.z * r * gg[2].z, c2.w * r * gg[2].w); *(uint2*)(hr + 512) = o;
      o.x = pack2(c3.x * r * gg[3].x, c3.y * r * gg[3].y); o.y = pack2(c3.z * r * gg[3].z, c3.w * r * gg[3].w); *(uint2*)(hr + 768) = o;
    }
  }
}

struct RowLin { size_t ld; DI size_t operator()(int m) const { return (size_t)m * ld; } };
struct RowCmp { size_t col0; DI size_t operator()(int m) const { return ((size_t)(m / 127) * 2048 + (size_t)(m % 127) * 16) * LDA_A + col0; } };

template <int NJ, class RowA>
DI void gemm_main(f32x16 (&acc)[2][NJ], const bf16_t* __restrict__ A, RowA rowA, size_t kstrideA, int m0, int Mmax,
                  const bf16_t* __restrict__ Bt, size_t ldb, int n0, int nk, char* smem) {
  constexpr int BROWS = 64 * NJ;
  constexpr int NBCH = BROWS * 8 / 256;
  constexpr int STAGE = (128 + BROWS) * 144;
  const int tid = TIDX, lane = tid & 63, wid = tid >> 6, wm = wid >> 1, wn = wid & 1;
  const int r = lane & 31, hh = lane >> 5;
  const bf16_t* ap[4]; const bf16_t* bp[NBCH]; int alo[4], blo[NBCH];
#pragma unroll
  for (int i = 0; i < 4; ++i) {
    const int c = tid + 256 * i, row = c >> 3, kc = c & 7;
    int m = m0 + row; m = m < Mmax ? m : Mmax - 1;
    ap[i] = A + rowA(m) + kc * 8; alo[i] = row * 144 + kc * 16;
  }
#pragma unroll
  for (int i = 0; i < NBCH; ++i) {
    const int c = tid + 256 * i, row = c >> 3, kc = c & 7;
    bp[i] = Bt + (size_t)(n0 + row) * ldb + kc * 8; blo[i] = 128 * 144 + row * 144 + kc * 16;
  }
#pragma unroll
  for (int i = 0; i < 2; ++i)
#pragma unroll
    for (int j = 0; j < NJ; ++j)
#pragma unroll
      for (int e = 0; e < 16; ++e) acc[i][j][e] = 0.f;
  uint4 x0a0, x0a1, x0a2, x0a3, x0b0, x0b1, x0b2, x0b3, x1a0, x1a1, x1a2, x1a3, x1b0, x1b1, x1b2, x1b3;
  x0b2 = x0b3 = x1b2 = x1b3 = make_uint4(0, 0, 0, 0);
#define G_LOAD(S, unused, KT) do { const size_t ko_ = (size_t)(KT); \
    S##a0 = *(const uint4*)(ap[0] + ko_ * kstrideA); S##a1 = *(const uint4*)(ap[1] + ko_ * kstrideA); \
    S##a2 = *(const uint4*)(ap[2] + ko_ * kstrideA); S##a3 = *(const uint4*)(ap[3] + ko_ * kstrideA); \
    S##b0 = *(const uint4*)(bp[0] + ko_ * 64); S##b1 = *(const uint4*)(bp[1] + ko_ * 64); \
    if (NBCH == 4) { S##b2 = *(const uint4*)(bp[NBCH - 2] + ko_ * 64); S##b3 = *(const uint4*)(bp[NBCH - 1] + ko_ * 64); } } while (0)
#define G_STORE(ST, S, unused) do { char* d_ = smem + (ST) * STAGE; \
    *(uint4*)(d_ + alo[0]) = S##a0; *(uint4*)(d_ + alo[1]) = S##a1; *(uint4*)(d_ + alo[2]) = S##a2; *(uint4*)(d_ + alo[3]) = S##a3; \
    *(uint4*)(d_ + blo[0]) = S##b0; *(uint4*)(d_ + blo[1]) = S##b1; \
    if (NBCH == 4) { *(uint4*)(d_ + blo[NBCH - 2]) = S##b2; *(uint4*)(d_ + blo[NBCH - 1]) = S##b3; } } while (0)
#define G_COMPUTE(ST) do { const char* sA = smem + (ST) * STAGE; const char* sB = sA + 128 * 144; \
    __builtin_amdgcn_s_setprio(1); \
    _Pragma("unroll") for (int ks = 0; ks < 4; ++ks) { \
      bf16x8 a_[2], b_[NJ]; \
      _Pragma("unroll") for (int i = 0; i < 2; ++i) a_[i] = *(const bf16x8*)(sA + (wm * 64 + i * 32 + r) * 144 + ks * 32 + hh * 16); \
      _Pragma("unroll") for (int j = 0; j < NJ; ++j) b_[j] = *(const bf16x8*)(sB + (wn * 32 * NJ + j * 32 + r) * 144 + ks * 32 + hh * 16); \
      _Pragma("unroll") for (int i = 0; i < 2; ++i) \
        _Pragma("unroll") for (int j = 0; j < NJ; ++j) acc[i][j] = MFMA32(a_[i], b_[j], acc[i][j]); \
    } __builtin_amdgcn_s_setprio(0); } while (0)
  __syncthreads();
  G_LOAD(x0, 0, 0);
  G_LOAD(x1, 0, 1);
  G_STORE(0, x0, 0);
  __syncthreads();
#pragma unroll 1
  for (int kt = 0; kt < nk; kt += 2) {
    G_LOAD(x0, 0, (kt + 2 < nk ? kt + 2 : nk - 1));
    G_COMPUTE(0);
    G_STORE(1, x1, 0);
    __syncthreads();
    G_LOAD(x1, 0, (kt + 3 < nk ? kt + 3 : nk - 1));
    G_COMPUTE(1);
    G_STORE(0, x0, 0);
    __syncthreads();
  }
#undef G_LOAD
#undef G_STORE
#undef G_COMPUTE
}

template <int NJ>
DI void acc_to_ct(const f32x16 (&acc)[2][NJ], float* Ct) {
  const int lane = TIDX & 63, wid = TIDX >> 6, wm = wid >> 1, wn = wid & 1;
  const int r = lane & 31, hh = lane >> 5;
#pragma unroll
  for (int i = 0; i < 2; ++i)
#pragma unroll
    for (int j = 0; j < NJ; ++j)
#pragma unroll
      for (int e = 0; e < 16; ++e) Ct[(wm * 64 + i * 32 + crow(e, hh)) * 132 + wn * 32 * NJ + j * 32 + r] = acc[i][j][e];
  __syncthreads();
}

DI void epi_rownorm(const float* Ct, float* rn, int W) {
  const int row = TIDX >> 1, grp = TIDX & 1;
  float ss = 0.f;
  for (int c0 = 0; c0 < 64; ++c0) { const int c = (c0 + row) & 63; const float v = Ct[row * 132 + grp * 64 + c]; ss += v * v; }
  if (W == 128) { ss += __shfl_xor(ss, 1); ss *= 0.5f; }
  rn[row * 2 + grp] = rsqrtf(ss * (1.f / 64.f) + 1e-6f);
  __syncthreads();
}
DI void epi_store64(const float* Ct, int cb, const float* rn, int grp, const float* gain, bool silu, const float* bias,
                    bf16_t* dst, size_t ldd, int dcol0, int m0, int Mmax) {
  const int tid = TIDX, c = (tid & 15) * 4;
  float4 gv = make_float4(1.f, 1.f, 1.f, 1.f), bv = make_float4(0.f, 0.f, 0.f, 0.f);
  if (rn) gv = *(const float4*)(gain + c);
  if (bias) bv = *(const float4*)(bias + c);
#pragma unroll
  for (int q = 0; q < 8; ++q) {
    const int row = (tid >> 4) + 16 * q;
    float4 v = *(const float4*)(Ct + row * 132 + cb + c);
    v.x += bv.x; v.y += bv.y; v.z += bv.z; v.w += bv.w;
    if (rn) { const float sc = rn[row * 2 + grp]; v.x *= sc * gv.x; v.y *= sc * gv.y; v.z *= sc * gv.z; v.w *= sc * gv.w; }
    if (silu) { v.x = siluf(v.x); v.y = siluf(v.y); v.z = siluf(v.z); v.w = siluf(v.w); }
    uint2 o; o.x = pack2(v.x, v.y); o.y = pack2(v.z, v.w);
    *(uint2*)(dst + (size_t)(m0 + row) * ldd + dcol0 + c) = o;
  }
}
DI void epi_storeT(const float* Ct, int cb, bf16_t* dstT, size_t ldT, int s0) {
  for (int idx = TIDX; idx < 64 * 128; idx += 256) {
    const int d = idx >> 7, tk = idx & 127;
    dstT[(size_t)d * ldT + s0 + tk] = f2bf(Ct[tk * 132 + cb + d]);
  }
}

DI void epi_storeKF(const float* Ct, int cb, const float* rn, int grp, const float* gain, bf16_t* dst) {
  const int slot = TIDX, r = slot & 31, d0 = (slot >> 5) * 8;
  float gq[8];
#pragma unroll
  for (int j = 0; j < 8; ++j) gq[j] = rn ? gain[d0 + j] : 1.f;
#pragma unroll
  for (int kt4 = 0; kt4 < 4; ++kt4) {
    const int row = kt4 * 32 + r;
    float v[8];
    {
      const float4 va = *(const float4*)(Ct + row * 132 + cb + d0), vb = *(const float4*)(Ct + row * 132 + cb + d0 + 4);
      v[0] = va.x; v[1] = va.y; v[2] = va.z; v[3] = va.w; v[4] = vb.x; v[5] = vb.y; v[6] = vb.z; v[7] = vb.w;
    }
    if (rn) { const float sc = rn[row * 2 + grp];
#pragma unroll
      for (int j = 0; j < 8; ++j) v[j] *= sc * gq[j]; }
    uint4 o; o.x = pack2(v[0], v[1]); o.y = pack2(v[2], v[3]); o.z = pack2(v[4], v[5]); o.w = pack2(v[6], v[7]);
    *(uint4*)(dst + kt4 * 2048 + slot * 8) = o;
  }
}
DI void epi_storeVF(const float* Ct, int cb, bf16_t* dst) {
  for (int idx = TIDX; idx < 1024; idx += 256) {
    const int kt4 = idx >> 8, slot = idx & 255, r = slot & 31, hh = (slot >> 5) & 1, s2 = (slot >> 6) & 1, dt = slot >> 7;
    float v[8];
#pragma unroll
    for (int j = 0; j < 8; ++j) {
      const int key = 16 * s2 + 8 * (j >> 2) + 4 * hh + (j & 3);
      v[j] = Ct[(kt4 * 32 + key) * 132 + cb + dt * 32 + r];
    }
    uint4 o; o.x = pack2(v[0], v[1]); o.y = pack2(v[2], v[3]); o.z = pack2(v[4], v[5]); o.w = pack2(v[6], v[7]);
    *(uint4*)(dst + kt4 * 2048 + slot * 8) = o;
  }
}

DI void inproj_tile(const Params& p, int l, int mt, int tn, char* smem) {
  f32x16 acc[2][2];
  const int m0 = mt * 128;
  gemm_main<2>(acc, p.h, RowLin{1024}, 64, m0, T_TOK, p.wt_in, 1024, tn * 128, 16, smem);
  float* Ct = (float*)smem; float* rn = (float*)(smem + 128 * 132 * 4);
  acc_to_ct<2>(acc, Ct);
  const int b = m0 / SEQ, s0 = m0 % SEQ;
  if (tn <= 3) {
    epi_rownorm(Ct, rn, 64);
    const float* g = tn < 2 ? p.a_q_norm + l * 64 : p.c_q_norm + l * 64;
    epi_store64(Ct, 0, rn, 0, g, false, nullptr, p.projA, LDA_A, tn * 128, m0, T_TOK);
    epi_store64(Ct, 64, rn, 1, g, false, nullptr, p.projA, LDA_A, tn * 128 + 64, m0, T_TOK);
  } else if (tn == 4) {
    epi_rownorm(Ct, rn, 128);
    const float* g = p.a_kv_norm + l * 128;
    epi_store64(Ct, 0, rn, 0, g, false, nullptr, p.projA, LDA_A, 512, m0, T_TOK);
    epi_store64(Ct, 64, rn, 1, g + 64, false, nullptr, p.projA, LDA_A, 576, m0, T_TOK);
  } else if (tn <= 8) {
    epi_store64(Ct, 0, nullptr, 0, nullptr, false, nullptr, p.projA, LDA_A, tn * 128, m0, T_TOK);
    epi_store64(Ct, 64, nullptr, 0, nullptr, false, nullptr, p.projA, LDA_A, tn * 128 + 64, m0, T_TOK);
  } else if (tn == 9) {
    epi_storeKF(Ct, 0, nullptr, 0, nullptr, p.kidxF + ((size_t)b * 64 + s0 / 32) * 2048);
    epi_store64(Ct, 64, nullptr, 0, nullptr, false, nullptr, p.projA, LDA_A, tn * 128 + 64, m0, T_TOK);
  } else if (tn == 10) {
    epi_rownorm(Ct, rn, 64);
    epi_store64(Ct, 0, nullptr, 0, nullptr, false, nullptr, p.projA, LDA_A, 1280, m0, T_TOK);
    epi_storeKF(Ct, 64, rn, 1, p.c_k_norm + (l * 3 + 1) * 64, p.kselF + ((size_t)b * 64 + s0 / 32) * 2048);
  } else if (tn == 11) {
    epi_rownorm(Ct, rn, 64);
    epi_storeKF(Ct, 0, rn, 0, p.c_k_norm + (l * 3 + 2) * 64, p.kwinF + ((size_t)b * 64 + s0 / 32) * 2048);
    epi_storeVF(Ct, 64, p.vselT + ((size_t)b * 64 + s0 / 32) * 2048);
  } else if (tn == 12) {
    epi_storeVF(Ct, 0, p.vwinT + ((size_t)b * 64 + s0 / 32) * 2048);
    for (int idx = TIDX; idx < 128 * 32; idx += 256) {
      const int row = idx >> 5, c = idx & 31;
      p.small[(size_t)(m0 + row) * 32 + c] = Ct[row * 132 + 64 + c];
    }
  } else if (tn <= 24) {
    const int c0 = (tn - 13) * 128;
    epi_store64(Ct, 0, nullptr, 0, nullptr, false, nullptr, p.projB, LDA_B, c0, m0, T_TOK);
    epi_store64(Ct, 64, nullptr, 0, nullptr, false, nullptr, p.projB, LDA_B, c0 + 64, m0, T_TOK);
  } else {
    const int c0 = (tn - 25) * 128;
    epi_store64(Ct, 0, nullptr, 0, nullptr, true, nullptr, p.projZ, LDA_Z, c0, m0, T_TOK);
    epi_store64(Ct, 64, nullptr, 0, nullptr, true, nullptr, p.projZ, LDA_Z, c0 + 64, m0, T_TOK);
  }
  __syncthreads();
}

DI void phase_inproj(const Params& p, int l, bool partB, int skipb, char* smem) {
  const int ntn = partB ? 13 : 20;
  const int ntiles = 256 * ntn;
  const int per = ntiles >> 3;
  const int vblk = blockIdx.x - skipb, nvb = gridDim.x - skipb;
  for (int idx = vblk >> 3; idx < per; idx += nvb >> 3) {
    const int t = (vblk & 7) * per + idx;
    const int mt = t / ntn; int tn = t % ntn;
    if (partB) tn += 12; else if (tn >= 12) tn += 13;
    inproj_tile(p, l, mt, tn, smem);
  }
}

DI void phaseB1(const Params& p, int l, char* smem) {
  float* qs = (float*)smem;
  float* ks = qs + 64 * 132;
  float* sm = ks + 64 * 132;
  float* gcum = sm; float* beta = sm + 64; float* eg = sm + 128; float* rq = sm + 192; float* rk = sm + 256;
  float* Am = qs;
  const int tid = TIDX, lane = tid & 63;
  const float* convw = p.b_conv + (size_t)l * 4 * 1536;
  for (int u = blockIdx.x; u < 2048; u += gridDim.x) {
    const int b = u >> 7, n = (u >> 2) & 31, hd = u & 3;
    const int tok0 = b * SEQ + n * 64;
    {
      const int cg = tid & 31, which = cg >> 4, c0 = (cg & 15) * 8;
      const int ch = which * 512 + hd * 128 + c0;
      float wv[4][8];
#pragma unroll
      for (int j = 0; j < 4; ++j) {
        const float4 wa = *(const float4*)(convw + j * 1536 + ch), wb = *(const float4*)(convw + j * 1536 + ch + 4);
        wv[j][0] = wa.x; wv[j][1] = wa.y; wv[j][2] = wa.z; wv[j][3] = wa.w; wv[j][4] = wb.x; wv[j][5] = wb.y; wv[j][6] = wb.z; wv[j][7] = wb.w;
      }
      float* dstl = which ? ks : qs;
      uint4 rw[8][4];
#pragma unroll
      for (int i8 = 0; i8 < 8; ++i8) {
        const int i = (tid >> 5) + 8 * i8;
#pragma unroll
        for (int j = 0; j < 4; ++j) {
          const int row = i - 3 + j;
          const bool valid = (n > 0) || (row >= 0);
          const bf16_t* src = p.projB + (size_t)(tok0 + (valid ? row : 0)) * LDA_B + ch;
          rw[i8][j] = valid ? *(const uint4*)src : make_uint4(0, 0, 0, 0);
        }
      }
#pragma unroll
      for (int i8 = 0; i8 < 8; ++i8) {
        const int i = (tid >> 5) + 8 * i8;
        float acc[8];
#pragma unroll
        for (int e = 0; e < 8; ++e) acc[e] = 0.f;
#pragma unroll
        for (int j = 0; j < 4; ++j) {
          const uint4 v = rw[i8][j];
          acc[0] += wv[j][0] * __uint_as_float(v.x << 16); acc[1] += wv[j][1] * __uint_as_float(v.x & 0xffff0000u);
          acc[2] += wv[j][2] * __uint_as_float(v.y << 16); acc[3] += wv[j][3] * __uint_as_float(v.y & 0xffff0000u);
          acc[4] += wv[j][4] * __uint_as_float(v.z << 16); acc[5] += wv[j][5] * __uint_as_float(v.z & 0xffff0000u);
          acc[6] += wv[j][6] * __uint_as_float(v.w << 16); acc[7] += wv[j][7] * __uint_as_float(v.w & 0xffff0000u);
        }
        *(float4*)(dstl + i * 132 + c0) = make_float4(siluf(acc[0]), siluf(acc[1]), siluf(acc[2]), siluf(acc[3]));
        *(float4*)(dstl + i * 132 + c0 + 4) = make_float4(siluf(acc[4]), siluf(acc[5]), siluf(acc[6]), siluf(acc[7]));
      }
    }
    __syncthreads();
    if (tid < 128) {
      const int row = tid & 63, which = tid >> 6;
      const float* src = which ? ks : qs;
      float ss = 0.f;
      for (int c0 = 0; c0 < 128; ++c0) { const int c = (c0 + row) & 127; const float v = src[row * 132 + c]; ss += v * v; }
      float rr = rsqrtf(ss + 1e-6f);
      if (which) rk[row] = rr; else rq[row] = rr * 0.08838834764831845f;
    } else if (tid < 192) {
      const int i = tid - 128;
      const float a = p.small[(size_t)(tok0 + i) * 32 + 8 + hd];
      const float bb = p.small[(size_t)(tok0 + i) * 32 + 12 + hd];
      const float xx = a + p.b_dt_bias[l * 4 + hd];
      const float ex = __expf(xx);
      const float sp = xx > 20.f ? xx : (ex < 0.01f ? ex * (1.f - ex * (0.5f - ex * (1.f / 3.f))) : __logf(1.f + ex));
      float g = -__expf(p.b_a_log[l * 4 + hd]) * sp;
#pragma unroll
      for (int o = 1; o < 64; o <<= 1) { const float v = __shfl_up(g, o); if (lane >= o) g += v; }
      gcum[i] = g; beta[i] = sigmoidf(bb); eg[i] = __expf(g);
    }
    __syncthreads();
    for (int idx = tid; idx < 64 * 128; idx += 256) {
      const int i = idx >> 7, c = idx & 127;
      qs[i * 132 + c] *= rq[i]; ks[i * 132 + c] *= rk[i];
    }
    __syncthreads();
    f32x16 accK, accQ;
    const int w3 = tid >> 6, r3 = tid & 31, h3 = (tid >> 5) & 1;
    const int it3 = w3 == 0 ? 0 : 1, jt3 = w3 == 2 ? 1 : 0;
    {
#pragma unroll
      for (int e = 0; e < 16; ++e) { accK[e] = 0.f; accQ[e] = 0.f; }
      if (w3 < 3) {
#pragma unroll
        for (int kk = 0; kk < 8; ++kk) {
          const float* pk_i = ks + (it3 * 32 + r3) * 132 + kk * 16 + h3 * 8;
          const float* pq_i = qs + (it3 * 32 + r3) * 132 + kk * 16 + h3 * 8;
          const float* pk_j = ks + (jt3 * 32 + r3) * 132 + kk * 16 + h3 * 8;
          const float4 a0 = *(const float4*)pk_i, a1 = *(const float4*)(pk_i + 4);
          const float4 q0 = *(const float4*)pq_i, q1 = *(const float4*)(pq_i + 4);
          const float4 b0 = *(const float4*)pk_j, b1 = *(const float4*)(pk_j + 4);
          uint4 ua, uq, ub;
          ua.x = pack2(a0.x, a0.y); ua.y = pack2(a0.z, a0.w); ua.z = pack2(a1.x, a1.y); ua.w = pack2(a1.z, a1.w);
          uq.x = pack2(q0.x, q0.y); uq.y = pack2(q0.z, q0.w); uq.z = pack2(q1.x, q1.y); uq.w = pack2(q1.z, q1.w);
          ub.x = pack2(b0.x, b0.y); ub.y = pack2(b0.z, b0.w); ub.z = pack2(b1.x, b1.y); ub.w = pack2(b1.z, b1.w);
          const bf16x8 fb = __builtin_bit_cast(bf16x8, ub);
          accK = MFMA32(__builtin_bit_cast(bf16x8, ua), fb, accK);
          accQ = MFMA32(__builtin_bit_cast(bf16x8, uq), fb, accQ);
        }
      }
      bf16_t* attn_g = p.b_attn + (size_t)u * 4096;
      const int itw = w3 < 3 ? it3 : 0, jtw = w3 < 3 ? jt3 : 1;
      const int j = jtw * 32 + r3;
      const float gj = gcum[j];
#pragma unroll
      for (int e = 0; e < 16; ++e) {
        const int ri = crow(e, h3), i = itw * 32 + ri;
        const float dec = i >= j ? __expf(gcum[i] - gj) : 0.f;
        accK[e] = i > j ? beta[i] * accK[e] * dec : 0.f;
        const float at = (w3 < 3 && i >= j) ? accQ[e] * dec : 0.f;
        attn_g[itw * 2048 + foff_perm(ri, j)] = f2bf(at);
      }
    }
    {
      bf16_t* qd = p.b_qd + (size_t)u * 8192;
      for (int idx = tid; idx < 64 * 64; idx += 256) {
        const int i = idx >> 6, c = (idx & 63) * 2;
        *(unsigned*)(qd + (i >> 5) * 4096 + foff_perm(i & 31, c)) = pack2(qs[i * 132 + c] * eg[i], qs[i * 132 + c + 1] * eg[i]);
      }
      bf16_t* kdT = p.b_kdT + (size_t)u * 8192;
      const float gl = gcum[63];
      for (int idx = tid; idx < 128 * 16; idx += 256) {
        const int k = idx & 127, i0 = (idx >> 7) * 4;
        uint2 o;
        o.x = pack2(ks[i0 * 132 + k] * __expf(gl - gcum[i0]), ks[(i0 + 1) * 132 + k] * __expf(gl - gcum[i0 + 1]));
        o.y = pack2(ks[(i0 + 2) * 132 + k] * __expf(gl - gcum[i0 + 2]), ks[(i0 + 3) * 132 + k] * __expf(gl - gcum[i0 + 3]));
        *(uint2*)(kdT + (k >> 5) * 2048 + foff_perm(k & 31, i0)) = o;
      }
      if (tid == 0) p.b_egl[u] = eg[63];
    }
    __syncthreads();
    if (w3 < 3) {
      const int j = jt3 * 32 + r3;
#pragma unroll
      for (int e = 0; e < 16; ++e) Am[(it3 * 32 + crow(e, h3)) * 68 + j] = accK[e];
    }
    __syncthreads();
    {
      float x[64];
      if (tid < 128) {
        const int ch = 1024 + hd * 128 + tid;
        const float w0 = convw[ch], w1 = convw[1536 + ch], w2 = convw[2 * 1536 + ch], w3 = convw[3 * 1536 + ch];
        const bf16_t* src = p.projB + (size_t)tok0 * LDA_B + ch;
        float x0 = 0.f, x1 = 0.f, x2 = 0.f;
        if (n > 0) { x0 = bf2f(src[-3 * LDA_B]); x1 = bf2f(src[-2 * LDA_B]); x2 = bf2f(src[-1 * LDA_B]); }
#pragma unroll
        for (int i = 0; i < 64; ++i) x[i] = bf2f(src[(size_t)i * LDA_B]);
        __builtin_amdgcn_sched_barrier(0);
#pragma unroll
        for (int i = 0; i < 64; ++i) {
          const float x3 = x[i];
          x[i] = siluf(w0 * x0 + w1 * x1 + w2 * x2 + w3 * x3) * beta[i];
          x0 = x1; x1 = x2; x2 = x3;
        }
      } else {
        const int c = tid - 128;
#pragma unroll
        for (int i = 0; i < 64; ++i) x[i] = ks[i * 132 + c] * beta[i] * eg[i];
      }
#pragma unroll
      for (int i = 1; i < 64; ++i) {
        float s0 = 0.f, s1 = 0.f, s2 = 0.f, s3 = 0.f;
#pragma unroll
        for (int j4 = 0; j4 < i; j4 += 4) {
          const float4 a = *(const float4*)(Am + i * 68 + j4);
          s0 += a.x * x[j4];
          if (j4 + 1 < i) s1 += a.y * x[j4 + 1];
          if (j4 + 2 < i) s2 += a.z * x[j4 + 2];
          if (j4 + 3 < i) s3 += a.w * x[j4 + 3];
        }
        x[i] = x[i] - ((s0 + s1) + (s2 + s3));
      }
      if (tid < 128) {
        bf16_t* uT = p.b_uT + (size_t)u * 8192 + (tid >> 5) * 2048 + (tid & 31) * 4;
#pragma unroll
        for (int i4 = 0; i4 < 16; ++i4) {
          uint2 o; o.x = pack2(x[4 * i4], x[4 * i4 + 1]); o.y = pack2(x[4 * i4 + 2], x[4 * i4 + 3]);
          *(uint2*)(uT + i4 * 128) = o;
        }
      } else {
        bf16_t* w = p.b_w + (size_t)u * 8192 + foff_perm(0, tid - 128);
#pragma unroll
        for (int i = 0; i < 64; ++i) w[(i >> 5) * 4096 + (i & 31) * 8] = f2bf(x[i]);
      }
    }
    __syncthreads();
  }
}

DI void phaseB2(const Params& p, int bh, char* smem, int n_begin, int n_end) {
  const int tid = TIDX, lane = tid & 63, wid = tid >> 6, r = lane & 31, hh = lane >> 5;
  const int b = bh >> 2, hd = bh & 3, v0 = wid * 32;
  bf16_t* L = (bf16_t*)smem;
  const bf16_t* wg = L; const bf16_t* qg = L + 8192; const bf16_t* kg = L + 16384; const bf16_t* ag = L + 24576;
  const int lo8 = (hh * 32 + r) * 8;
  f32x16 S[4];
  const float* sst_in = p.b_state + ((size_t)(n_begin == B2_S1 ? 0 : 64) * 256 + (size_t)bh * 256 + tid) * 64;
  float* sst = p.b_state + ((size_t)(n_end == B2_S1 ? 0 : 64) * 256 + (size_t)bh * 256 + tid) * 64;
  if (n_begin == 0) {
#pragma unroll
    for (int T = 0; T < 4; ++T)
#pragma unroll
      for (int e = 0; e < 16; ++e) S[T][e] = 0.f;
  } else {
#pragma unroll
    for (int T = 0; T < 4; ++T)
#pragma unroll
      for (int q4 = 0; q4 < 4; ++q4) {
        const float4 v = *(const float4*)(sst_in + T * 16 + q4 * 4);
        S[T][q4 * 4] = v.x; S[T][q4 * 4 + 1] = v.y; S[T][q4 * 4 + 2] = v.z; S[T][q4 * 4 + 3] = v.w;
      }
  }
  const float eglv = p.b_egl[(b * 32 + (lane & 31)) * 4 + hd];
  uint4 pw0, pw1, pw2, pw3, pq0, pq1, pq2, pq3, pk0, pk1, pk2, pk3, pa0, pa1;
  uint2 pu0, pu1, pu2, pu3, pu4, pu5, pu6, pu7;
#define B2_LOAD(N) do { const size_t c_ = (size_t)((b * 32 + (N)) * 4 + hd); \
    const uint4* w_ = (const uint4*)(p.b_w + c_ * 8192) + tid; const uint4* q_ = (const uint4*)(p.b_qd + c_ * 8192) + tid; \
    const uint4* k_ = (const uint4*)(p.b_kdT + c_ * 8192) + tid; const uint4* a_ = (const uint4*)(p.b_attn + c_ * 4096) + tid; \
    pw0 = w_[0]; pw1 = w_[256]; pw2 = w_[512]; pw3 = w_[768]; pq0 = q_[0]; pq1 = q_[256]; pq2 = q_[512]; pq3 = q_[768]; \
    pk0 = k_[0]; pk1 = k_[256]; pk2 = k_[512]; pk3 = k_[768]; pa0 = a_[0]; pa1 = a_[256]; \
    } while (0)
#define B2_LOADU(N) do { const size_t c_ = (size_t)((b * 32 + (N)) * 4 + hd); \
    const bf16_t* u_ = p.b_uT + c_ * 8192 + (v0 >> 5) * 2048 + (hh * 32 + r) * 4; \
    pu0 = *(const uint2*)(u_); pu1 = *(const uint2*)(u_ + 256); pu2 = *(const uint2*)(u_ + 512); pu3 = *(const uint2*)(u_ + 768); \
    pu4 = *(const uint2*)(u_ + 1024); pu5 = *(const uint2*)(u_ + 1280); pu6 = *(const uint2*)(u_ + 1536); pu7 = *(const uint2*)(u_ + 1792); } while (0)
#define B2_STORE() do { uint4* l_ = (uint4*)L + tid; \
    l_[0] = pw0; l_[256] = pw1; l_[512] = pw2; l_[768] = pw3; l_[1024] = pq0; l_[1280] = pq1; l_[1536] = pq2; l_[1792] = pq3; \
    l_[2048] = pk0; l_[2304] = pk1; l_[2560] = pk2; l_[2816] = pk3; l_[3072] = pa0; l_[3328] = pa1; } while (0)
  __syncthreads();
  B2_LOAD(n_begin);
  B2_LOADU(n_begin);
  B2_STORE();
  __syncthreads();
#pragma unroll 1
  for (int n = n_begin; n < n_end; ++n) {
    B2_LOAD(n + 1 < 32 ? n + 1 : n);
    f32x16 vn[2], o[2];
#pragma unroll
    for (int it = 0; it < 2; ++it) {
      f32x16 aw;
#pragma unroll
      for (int e = 0; e < 16; ++e) aw[e] = 0.f;
#pragma unroll
      for (int T = 0; T < 4; ++T)
#pragma unroll
        for (int s = 0; s < 2; ++s) aw = MFMA32(ld16(wg + (it * 4096 + (T * 2 + s) * 512) + lo8), pack8(S[T], s), aw);
#pragma unroll
      for (int g = 0; g < 4; ++g) {
        const uint2 uu = it == 0 ? (g == 0 ? pu0 : g == 1 ? pu1 : g == 2 ? pu2 : pu3) : (g == 0 ? pu4 : g == 1 ? pu5 : g == 2 ? pu6 : pu7);
        vn[it][4 * g + 0] = __uint_as_float(uu.x << 16) - aw[4 * g + 0];
        vn[it][4 * g + 1] = __uint_as_float(uu.x & 0xffff0000u) - aw[4 * g + 1];
        vn[it][4 * g + 2] = __uint_as_float(uu.y << 16) - aw[4 * g + 2];
        vn[it][4 * g + 3] = __uint_as_float(uu.y & 0xffff0000u) - aw[4 * g + 3];
      }
    }
    B2_LOADU(n + 1 < 32 ? n + 1 : n);
    bf16x8 Vb[2][2];
#pragma unroll
    for (int jt = 0; jt < 2; ++jt) { Vb[jt][0] = pack8(vn[jt], 0); Vb[jt][1] = pack8(vn[jt], 1); }
#pragma unroll
    for (int it = 0; it < 2; ++it) {
#pragma unroll
      for (int e = 0; e < 16; ++e) o[it][e] = 0.f;
#pragma unroll
      for (int T = 0; T < 4; ++T)
#pragma unroll
        for (int s = 0; s < 2; ++s) o[it] = MFMA32(ld16(qg + (it * 4096 + (T * 2 + s) * 512) + lo8), pack8(S[T], s), o[it]);
#pragma unroll
      for (int jt = 0; jt < 2; ++jt)
#pragma unroll
        for (int s = 0; s < 2; ++s)
          o[it] = MFMA32(ld16(ag + (it * 2048 + (jt * 2 + s) * 512) + lo8), Vb[jt][s], o[it]);
    }
    const float egl = __shfl(eglv, n);
#pragma unroll
    for (int T = 0; T < 4; ++T) {
      f32x16 acc;
#pragma unroll
      for (int e = 0; e < 16; ++e) acc[e] = S[T][e] * egl;
#pragma unroll
      for (int jt = 0; jt < 2; ++jt)
#pragma unroll
        for (int s = 0; s < 2; ++s)
          acc = MFMA32(ld16(kg + (T * 2048 + (jt * 2 + s) * 512) + lo8), Vb[jt][s], acc);
      S[T] = acc;
    }
    asm volatile("s_waitcnt lgkmcnt(0)\n\ts_barrier" ::: "memory");
    B2_STORE();
    asm volatile("s_waitcnt lgkmcnt(0)\n\ts_barrier" ::: "memory");
    {
      bf16_t* og = p.ob + (size_t)(b * SEQ + n * 64) * 512 + hd * 128 + v0 + r;
#pragma unroll
      for (int it = 0; it < 2; ++it)
#pragma unroll
        for (int e = 0; e < 16; ++e) og[(size_t)(it * 32 + crow(e, hh)) * 512] = f2bf(o[it][e]);
    }
  }
  if (n_end < 32) {
#pragma unroll
    for (int T = 0; T < 4; ++T)
#pragma unroll
      for (int q4 = 0; q4 < 4; ++q4)
        *(float4*)(sst + T * 16 + q4 * 4) = make_float4(S[T][q4 * 4], S[T][q4 * 4 + 1], S[T][q4 * 4 + 2], S[T][q4 * 4 + 3]);
  }
  __syncthreads();
#undef B2_LOAD
#undef B2_LOADU
#undef B2_STORE
}

DI void setup_lut(const Params& p, float* lut) {
#pragma unroll
  for (int q = 0; q < 4; ++q) {
    const int idx = TIDX + 256 * q;
    const int hd = idx >> 7, d = idx & 127;
    int bk;
    if (d < 16) bk = d;
    else {
      const float lr2 = logf((float)d / 16.f) / 2.0794415416798357f;
      bk = 16 + (int)(lr2 * 16.f);
      bk = bk < 31 ? bk : 31;
    }
    lut[idx] = p.rel_bias[bk * 8 + hd] * 1.4426950408889634f;
  }
  __syncthreads();
}

template <int MODE>
DI void attn_branch(f32x16 (&oacc)[2], float& m_run, float& l_run, const bf16x8 (&qf)[4],
                    const bf16_t* __restrict__ Kb, const bf16_t* __restrict__ Vt,
                    int kt_begin, int kt_end, int t, const float* lut, const unsigned* maskrow, unsigned selm) {
  const int lane = TIDX & 63, r = lane & 31, hh = lane >> 5;
  unsigned orm = 0xffffffffu;
  if (MODE == 1) {
    orm = selm;
#pragma unroll
    for (int o = 32; o >= 1; o >>= 1) orm |= __shfl_xor(orm, o);
    orm = __builtin_amdgcn_readfirstlane(orm);
  }
  int kt = kt_begin;
  if (MODE == 1) { while (kt < kt_end && !((orm >> (kt >> 1)) & 1u)) ++kt; }
  if (kt >= kt_end) return;
  const bf16_t* kp = Kb + (hh * 32 + r) * 8;
  const bf16_t* vp = Vt + (hh * 32 + r) * 8;
  unsigned n_mb = 0xffffffffu, c_mb = 0xffffffffu;
#define A_LOAD(P, KT) do { const size_t k0_ = (size_t)(KT) * 2048; const bf16_t* kq_ = kp + k0_; const bf16_t* vq_ = vp + k0_; \
    P##k0 = ld16(kq_); P##k1 = ld16(kq_ + 512); P##k2 = ld16(kq_ + 1024); P##k3 = ld16(kq_ + 1536); \
    P##v00 = ld16(vq_); P##v01 = ld16(vq_ + 512); P##v10 = ld16(vq_ + 1024); P##v11 = ld16(vq_ + 1536); \
    if (MODE == 0) P##mb = maskrow[KT]; } while (0)
  bf16x8 c_k0, c_k1, c_k2, c_k3, c_v00, c_v01, c_v10, c_v11;
  bf16x8 n_k0, n_k1, n_k2, n_k3, n_v00, n_v01, n_v10, n_v11;
  A_LOAD(c_, kt);
#pragma unroll 1
  while (kt < kt_end) {
    int kn = kt + 1;
    if (MODE == 1) { while (kn < kt_end && !((orm >> (kn >> 1)) & 1u)) ++kn; }
    const int kl = kn < kt_end ? kn : kt;
    A_LOAD(n_, kl);
    const int key0 = kt * 32;
    unsigned mb = c_mb;
    if (MODE == 1) mb = ((selm >> (key0 >> 6)) & 1u) ? 0xffffffffu : 0u;
    f32x16 s;
#pragma unroll
    for (int e = 0; e < 16; ++e) s[e] = 0.f;
    s = MFMA32(c_k0, qf[0], s); s = MFMA32(c_k1, qf[1], s); s = MFMA32(c_k2, qf[2], s); s = MFMA32(c_k3, qf[3], s);
    float tmax = -1e30f;
    f32x16 pv;
    const int q0u = __builtin_amdgcn_readfirstlane(t - r);
    const bool far = (MODE != 3) && (q0u - (key0 + 31) >= 127);
    if (far) {
      const float b127 = lut[127];
      const unsigned mbs = mb >> (4 * hh);
      const int dbase = t - key0 - 4 * hh;
#pragma unroll
      for (int e = 0; e < 16; ++e) {
        const int ce = (e & 3) + 8 * (e >> 2);
        bool ok;
        if (MODE == 0) ok = (mbs & (1u << ce)) != 0u;
        else if (MODE == 1) ok = mb != 0u;
        else ok = (dbase - ce) < 512;
        const float lg = __builtin_fmaf(s[e], 0.18033688011112042f, b127);
        pv[e] = ok ? lg : -1e30f;
        tmax = fmaxf(tmax, pv[e]);
      }
    } else {
#pragma unroll
      for (int e = 0; e < 16; ++e) {
        const int kk = crow(e, hh), kidx = key0 + kk;
        const int pos = MODE == 3 ? 16 * kidx + 31 : kidx;
        const int dist = t - pos;
        bool ok = dist >= 0 && ((mb >> kk) & 1u);
        if (MODE == 2) ok = ok && dist < 512;
        if (MODE == 3) ok = ok && kidx < 127;
        int di = dist < 0 ? 0 : (dist > 127 ? 127 : dist);
        const float lg = __builtin_fmaf(s[e], 0.18033688011112042f, lut[di]);
        pv[e] = ok ? lg : -1e30f;
        tmax = fmaxf(tmax, pv[e]);
      }
    }
    tmax = fmaxf(tmax, __shfl_xor(tmax, 32));
    const float m_new = fmaxf(m_run, tmax);
    if (__ballot(m_new != m_run) != 0ull) {
      const float alpha = __builtin_amdgcn_exp2f(m_run - m_new);
      l_run *= alpha; m_run = m_new;
#pragma unroll
      for (int e = 0; e < 16; ++e) { oacc[0][e] *= alpha; oacc[1][e] *= alpha; }
    }
    const float m_use = fmaxf(m_run, -1e29f);
    float psum = 0.f;
#pragma unroll
    for (int e = 0; e < 16; ++e) {
      const float ev = __builtin_amdgcn_exp2f(pv[e] - m_use);
      pv[e] = ev; psum += ev;
    }
    l_run += psum;
    const bf16x8 pf0 = pack8(pv, 0), pf1 = pack8(pv, 1);
    oacc[0] = MFMA32(c_v00, pf0, oacc[0]); oacc[0] = MFMA32(c_v01, pf1, oacc[0]);
    oacc[1] = MFMA32(c_v10, pf0, oacc[1]); oacc[1] = MFMA32(c_v11, pf1, oacc[1]);
    c_mb = n_mb; c_k0 = n_k0; c_k1 = n_k1; c_k2 = n_k2; c_k3 = n_k3; c_v00 = n_v00; c_v01 = n_v01; c_v10 = n_v10; c_v11 = n_v11;
    kt = kn;
  }
#undef A_LOAD
}

DI void store_y(const f32x16 (&o)[2], bf16_t* yrow) {
  const int lane = TIDX & 63, hh = lane >> 5;
#pragma unroll
  for (int dt = 0; dt < 2; ++dt)
#pragma unroll
    for (int g = 0; g < 4; ++g) {
      bf16_t* ptr = yrow + dt * 32 + 8 * g + 4 * hh;
      const uint2 z = *(const uint2*)ptr;
      uint2 w;
      w.x = pack2(o[dt][4 * g + 0] * __uint_as_float(z.x << 16), o[dt][4 * g + 1] * __uint_as_float(z.x & 0xffff0000u));
      w.y = pack2(o[dt][4 * g + 2] * __uint_as_float(z.y << 16), o[dt][4 * g + 3] * __uint_as_float(z.y & 0xffff0000u));
      *(uint2*)ptr = w;
    }
}

DI int wave_sum6(unsigned c) {
  int tot = 0;
#pragma unroll
  for (int bb = 0; bb < 6; ++bb) tot += __popcll(__ballot((c >> bb) & 1u)) << bb;
  return tot;
}
DI void a1_select(const Params& p, const float* scrow, int t, size_t tokrow, int lane) {
  unsigned long long myword = 0ull;
  if (t >= 256) {
    unsigned a[32];
    unsigned valid = 0u;
#pragma unroll
    for (int i = 0; i < 32; ++i) {
      const int key = i * 64 + lane;
      const unsigned bits = __float_as_uint(scrow[key]);
      a[i] = (bits & 0x80000000u) ? ~bits : (bits | 0x80000000u);
      valid |= (key <= t ? 1u : 0u) << i;
    }
#pragma unroll
    for (int st = 0; st < 5; ++st) {
      const int j = 16 >> st;
      const unsigned m = st == 0 ? 0x0000FFFFu : st == 1 ? 0x00FF00FFu : st == 2 ? 0x0F0F0F0Fu : st == 3 ? 0x33333333u : 0x55555555u;
#pragma unroll
      for (int k = 0; k < 32; ++k) {
        if ((k & j) == 0) {
          const unsigned tt = ((a[k] >> j) ^ a[k + j]) & m;
          a[k + j] ^= tt;
          a[k] ^= tt << j;
        }
      }
    }
    unsigned active = valid, above = 0u;
    int need = 256;
    bool done = false;
#pragma unroll
    for (int pb = 31; pb >= 0; --pb) {
      if (!done) {
        const unsigned m1 = active & a[pb];
        const int c1 = wave_sum6(__popc(m1));
        if (c1 >= need) { active = m1; done = (c1 == need); }
        else { need -= c1; above |= m1; active &= ~a[pb]; }
      }
    }
    int run = 0;
    const unsigned long long lowmask = (1ull << lane) - 1ull;
    const int nties = wave_sum6(__popc(active));
    if (nties == need) {
      const unsigned selb = above | active;
#pragma unroll
      for (int i = 0; i < 32; ++i) {
        const unsigned long long sb = __ballot((selb >> i) & 1u);
        if (lane == i) myword = sb;
      }
    } else
#pragma unroll
    for (int i = 0; i < 32; ++i) {
      const bool tie = (active >> i) & 1u;
      const unsigned long long tb = __ballot(tie);
      const int pre = __popcll(tb & lowmask);
      const bool sel = ((above >> i) & 1u) || (tie && (run + pre) < need);
      run += __popcll(tb);
      const unsigned long long sb = __ballot(sel);
      if (lane == i) myword = sb;
    }
  } else {
#pragma unroll
    for (int i = 0; i < 32; ++i) {
      const unsigned long long sb = __ballot(i * 64 + lane <= t);
      if (lane == i) myword = sb;
    }
  }
  if (lane < 32) ((unsigned long long*)p.bm)[tokrow * 32 + lane] = myword;
}

DI void phaseA1(const Params& p, int vblock, int nvblocks, int ubegin, int uend, char* smem) {
  float* sc = (float*)smem;
  const int tid = TIDX, lane = tid & 63, wid = tid >> 6, r = lane & 31, hh = lane >> 5;
#pragma unroll 1
  for (int u0 = ubegin + vblock; u0 < uend; u0 += nvblocks) {
    const int u = 4095 - u0;
    const int b = u >> 8, q0 = (u & 255) * 8;
    const size_t tokb = (size_t)b * SEQ;
    const int qa = ((r >> 2) & 1) * 2 + (r >> 4), ha = (r & 3) + 4 * ((r >> 3) & 1);
    bf16x8 af0[4], af1[4];
#pragma unroll
    for (int ks = 0; ks < 4; ++ks) {
      af0[ks] = ld16(p.projA + (tokb + q0 + qa) * LDA_A + 640 + ha * 64 + ks * 16 + hh * 8);
      af1[ks] = ld16(p.projA + (tokb + q0 + 4 + qa) * LDA_A + 640 + ha * 64 + ks * 16 + hh * 8);
    }
    float wr0[16], wr1[16];
    {
      const float4* sp = (const float4*)(p.small + (tokb + q0 + hh * 2) * 32);
      const float4 wa = sp[0], wb = sp[1], wc = sp[8], wd = sp[9], we = sp[32], wf = sp[33], wg = sp[40], wh = sp[41];
      __builtin_amdgcn_sched_barrier(0);
      const float cs = 0.044194173824159216f;
      wr0[0] = wa.x * cs; wr0[1] = wa.y * cs; wr0[2] = wa.z * cs; wr0[3] = wa.w * cs; wr0[4] = wb.x * cs; wr0[5] = wb.y * cs; wr0[6] = wb.z * cs; wr0[7] = wb.w * cs;
      wr0[8] = wc.x * cs; wr0[9] = wc.y * cs; wr0[10] = wc.z * cs; wr0[11] = wc.w * cs; wr0[12] = wd.x * cs; wr0[13] = wd.y * cs; wr0[14] = wd.z * cs; wr0[15] = wd.w * cs;
      wr1[0] = we.x * cs; wr1[1] = we.y * cs; wr1[2] = we.z * cs; wr1[3] = we.w * cs; wr1[4] = wf.x * cs; wr1[5] = wf.y * cs; wr1[6] = wf.z * cs; wr1[7] = wf.w * cs;
      wr1[8] = wg.x * cs; wr1[9] = wg.y * cs; wr1[10] = wg.z * cs; wr1[11] = wg.w * cs; wr1[12] = wh.x * cs; wr1[13] = wh.y * cs; wr1[14] = wh.z * cs; wr1[15] = wh.w * cs;
    }
    const int nt = (q0 + 7) / 32 + 1;
    const bf16_t* kib = p.kidxF + (size_t)b * 64 * 2048 + (hh * 32 + r) * 8;
#pragma unroll 1
    for (int kb = wid; kb < nt; kb += 16) {
      bf16x8 kf[4][4];
#pragma unroll
      for (int j = 0; j < 4; ++j) {
        const int kt = kb + 4 * j < nt ? kb + 4 * j : kb;
        const bf16_t* q_ = kib + (size_t)kt * 2048;
        kf[j][0] = ld16(q_); kf[j][1] = ld16(q_ + 512); kf[j][2] = ld16(q_ + 1024); kf[j][3] = ld16(q_ + 1536);
      }
#pragma unroll
      for (int j = 0; j < 4; ++j) {
        const int kt = kb + 4 * j;
        if (kt < nt) {
          f32x16 s0, s1;
#pragma unroll
          for (int e = 0; e < 16; ++e) { s0[e] = 0.f; s1[e] = 0.f; }
#pragma unroll
          for (int ks = 0; ks < 4; ++ks) { s0 = MFMA32(af0[ks], kf[j][ks], s0); s1 = MFMA32(af1[ks], kf[j][ks], s1); }
          float a0 = 0.f, a1 = 0.f, a2 = 0.f, a3 = 0.f;
#pragma unroll
          for (int e = 0; e < 8; ++e) {
            a0 += wr0[e] * fmaxf(s0[e], 0.f); a1 += wr0[8 + e] * fmaxf(s0[8 + e], 0.f);
            a2 += wr1[e] * fmaxf(s1[e], 0.f); a3 += wr1[8 + e] * fmaxf(s1[8 + e], 0.f);
          }
          const int key = kt * 32 + r;
          sc[(hh * 2 + 0) * 2048 + key] = a0 + 0.0f;
          sc[(hh * 2 + 1) * 2048 + key] = a1 + 0.0f;
          sc[(4 + hh * 2 + 0) * 2048 + key] = a2 + 0.0f;
          sc[(4 + hh * 2 + 1) * 2048 + key] = a3 + 0.0f;
        }
      }
    }
    __syncthreads();
    a1_select(p, sc + wid * 2048, q0 + wid, tokb + q0 + wid, lane);
    a1_select(p, sc + (4 + wid) * 2048, q0 + 4 + wid, tokb + q0 + 4 + wid, lane);
    __syncthreads();
  }
}

DI void phaseA2(const Params& p, const float* lut, bool dry) {
  const int lane = TIDX & 63, wid = TIDX >> 6, r = lane & 31, hh = lane >> 5;
#pragma unroll 1
  for (int u = blockIdx.x * 4 + wid; u < 4096; u += gridDim.x * 4) {
    const int itp = (u >> 11) & 1, kq = (u >> 6) & 31;
    const int qb = kq < 16 ? (itp ? 32 + kq : 63 - kq) : (itp ? kq - 16 : 47 - kq), b = (u >> 2) & 15, hd = u & 3;
    const int t = qb * 32 + r;
    const size_t tok = (size_t)b * SEQ + t;
    bf16x8 qf[4];
#pragma unroll
    for (int ks = 0; ks < 4; ++ks) qf[ks] = ld16(p.projA + tok * LDA_A + hd * 64 + ks * 16 + hh * 8);
    f32x16 oacc[2];
#pragma unroll
    for (int e = 0; e < 16; ++e) { oacc[0][e] = 0.f; oacc[1][e] = 0.f; }
    float m_run = -1e30f, l_run = 0.f;
    attn_branch<0>(oacc, m_run, l_run, qf, p.akv + ((size_t)b * 4 + hd) * 64 * 2048,
                   p.avT + ((size_t)b * 4 + hd) * 64 * 2048, 0, qb + 1, t, lut + hd * 128, p.bm + tok * 64, 0u);
    const float lt = l_run + __shfl_xor(l_run, 32);
    const float inv = lt > 0.f ? 1.f / lt : 0.f;
#pragma unroll
    for (int e = 0; e < 16; ++e) { oacc[0][e] *= inv; oacc[1][e] *= inv; }
    if (!dry) store_y(oacc, p.projZ + tok * LDA_Z + hd * 64);
  }
}

DI void phaseC2a(const Params& p, float* lut) {
  const int lane = TIDX & 63, wid = TIDX >> 6, r = lane & 31, hh = lane >> 5;
  const int ubk = (int)blockIdx.x - (int)(gridDim.x >> 1);
#pragma unroll 1
  for (int u = ubk * 4 + wid; ubk >= 0 && u < 1024; u += (gridDim.x >> 1) * 4) {
    const int b = u >> 6, qb = u & 63;
    const int t = qb * 32 + r;
    const size_t tok = (size_t)b * SEQ + t;
    float mainv[16], e3[16];
#pragma unroll
    for (int i = 0; i < 16; ++i) { mainv[i] = 0.f; e3[i] = 0.f; }
    bf16_t* kcs = (bf16_t*)(lut + 1024 + 4 * 32 * 33);
    __syncthreads();
    {
      const uint4* src_ = (const uint4*)(p.kc + (size_t)b * 4 * 2048) + TIDX;
      const uint4 t0 = src_[0], t1 = src_[256], t2 = src_[512], t3 = src_[768];
      uint4* d_ = (uint4*)kcs + TIDX;
      d_[0] = t0; d_[256] = t1; d_[512] = t2; d_[768] = t3;
    }
    __syncthreads();
    const bf16_t* kcb = kcs + (hh * 32 + r) * 8;
#pragma unroll 1
    for (int hd = 0; hd < 4; ++hd) {
      bf16x8 qf[4];
#pragma unroll
      for (int ks = 0; ks < 4; ++ks) qf[ks] = ld16(p.projA + tok * LDA_A + 256 + hd * 64 + ks * 16 + hh * 8);
      float mx = -1e30f, sum = 0.f;
#pragma unroll 1
      for (int pass = 0; pass < 2; ++pass) {
#pragma unroll 1
        for (int tile = 0; tile < 4; ++tile) {
          f32x16 s;
#pragma unroll
          for (int e = 0; e < 16; ++e) s[e] = 0.f;
#pragma unroll
          for (int ks = 0; ks < 4; ++ks) s = MFMA32(ld16(kcb + tile * 2048 + ks * 512), qf[ks], s);
          int tt0 = t; asm volatile("" : "+v"(tt0));
#pragma unroll
          for (int e = 0; e < 16; ++e) {
            const int nn = tile * 32 + crow(e, hh);
            const int dist = tt0 - (16 * nn + 31);
            const bool ok = dist >= 0 && nn < 127;
            const int di = dist < 0 ? 0 : (dist > 127 ? 127 : dist);
            const float lg = __builtin_fmaf(s[e], 0.18033688011112042f, lut[(4 + hd) * 128 + di]);
            if (pass == 0) mx = fmaxf(mx, ok ? lg : -1e30f);
            else sum += ok ? __builtin_amdgcn_exp2f(lg - mx) : 0.f;
          }
        }
        if (pass == 0) mx = fmaxf(mx, __shfl_xor(mx, 32));
      }
      sum += __shfl_xor(sum, 32);
      const float inv = sum > 0.f ? 1.f / sum : 0.f;
#pragma unroll
      for (int tile = 0; tile < 4; ++tile) {
        f32x16 s;
#pragma unroll
        for (int e = 0; e < 16; ++e) s[e] = 0.f;
#pragma unroll
        for (int ks = 0; ks < 4; ++ks) s = MFMA32(ld16(kcb + tile * 2048 + ks * 512), qf[ks], s);
        int tt = t; asm volatile("" : "+v"(tt));
#pragma unroll
        for (int e = 0; e < 16; ++e) {
          const int nn = tile * 32 + crow(e, hh);
          const int dist = tt - (16 * nn + 31);
          const bool ok = dist >= 0 && nn < 127;
          const int di = dist < 0 ? 0 : (dist > 127 ? 127 : dist);
          const float lg = __builtin_fmaf(s[e], 0.18033688011112042f, lut[(4 + hd) * 128 + di]);
          s[e] = ok ? __builtin_amdgcn_exp2f(lg - mx) * inv : 0.f;
        }
#pragma unroll
        for (int g = 0; g < 4; ++g) {
          const float a3 = s[4 * g + 3];
          mainv[tile * 4 + g] += s[4 * g] + s[4 * g + 1] + s[4 * g + 2] + a3;
          e3[tile * 4 + g] += a3;
        }
      }
    }
    float recv[16], imp[16];
#pragma unroll
    for (int i = 0; i < 16; ++i) recv[i] = __shfl_xor(e3[i], 32);
#pragma unroll
    for (int i = 0; i < 16; ++i) {
      const float prev = i > 0 ? recv[i - 1] : 0.f;
      imp[i] = mainv[i] + (hh ? recv[i] : prev);
    }
    const int cur = t >> 6;
    const int curm1 = cur > 0 ? cur - 1 : 0;
#pragma unroll
    for (int i = 0; i < 16; ++i) {
      const int j = 2 * i + hh;
      const bool adm = j <= cur, forced = (j == 0) || (j == cur) || (j == curm1);
      imp[i] = adm ? (forced ? 1e9f : imp[i]) : -1e30f;
    }
    float* vals = (float*)lut + 1024 + (wid * 32 + r) * 33;
    asm volatile("s_waitcnt lgkmcnt(0)" ::: "memory");
#pragma unroll
    for (int i = 0; i < 16; ++i) vals[2 * i + hh] = imp[i];
    asm volatile("s_waitcnt lgkmcnt(0)" ::: "memory");
    unsigned own = 0u;
#pragma unroll 1
    for (int i = 0; i < 16; ++i) {
      const int j = 2 * i + hh;
      const float v = vals[j];
      int rank = 0;
#pragma unroll 8
      for (int k = 0; k < 32; ++k) {
        const float o = vals[k];
        rank += (o > v || (o == v && k < j)) ? 1 : 0;
      }
      if (rank < 16 && j <= cur) own |= 1u << j;
    }
    asm volatile("s_waitcnt lgkmcnt(0)" ::: "memory");
    own |= __shfl_xor(own, 32);
    if (hh == 0) p.selmask[tok] = own;
  }
}

DI void phaseC2b(const Params& p, const float* lut, bool dry) {
  const int lane = TIDX & 63, wid = TIDX >> 6, r = lane & 31, hh = lane >> 5;
#pragma unroll 1
  for (int u = blockIdx.x * 4 + wid; u < 4096; u += gridDim.x * 4) {
    const int itp = (u >> 11) & 1, kq = (u >> 6) & 31;
    const int qb = itp ? kq : 63 - kq, b = (u >> 2) & 15, hd = u & 3;
    const int t = qb * 32 + r;
    const size_t tok = (size_t)b * SEQ + t;
    bf16x8 qf[4];
#pragma unroll
    for (int ks = 0; ks < 4; ++ks) qf[ks] = ld16(p.projA + tok * LDA_A + 256 + hd * 64 + ks * 16 + hh * 8);
    const float* lh = lut + (4 + hd) * 128;
    const unsigned selm = p.selmask[tok];
    const float gt0 = p.small[tok * 32 + 16 + hd * 3], gt1 = p.small[tok * 32 + 17 + hd * 3], gt2 = p.small[tok * 32 + 18 + hd * 3];
    f32x16 tot[2];
#pragma unroll
    for (int e = 0; e < 16; ++e) { tot[0][e] = 0.f; tot[1][e] = 0.f; }
#pragma unroll 1
    for (int br = 0; br < 3; ++br) {
      f32x16 oacc[2];
#pragma unroll
      for (int e = 0; e < 16; ++e) { oacc[0][e] = 0.f; oacc[1][e] = 0.f; }
      float m_run = -1e30f, l_run = 0.f;
      if (br == 0)
        attn_branch<3>(oacc, m_run, l_run, qf, p.kc + (size_t)b * 4 * 2048, p.vcT + (size_t)b * 4 * 2048, 0, 4, t, lh, nullptr, 0u);
      else if (br == 1)
        attn_branch<1>(oacc, m_run, l_run, qf, p.kselF + (size_t)b * 64 * 2048, p.vselT + (size_t)b * 64 * 2048, 0, qb + 1, t, lh, nullptr, selm);
      else {
        const int kb = qb - 16 > 0 ? qb - 16 : 0;
        attn_branch<2>(oacc, m_run, l_run, qf, p.kwinF + (size_t)b * 64 * 2048, p.vwinT + (size_t)b * 64 * 2048, kb, qb + 1, t, lh, nullptr, 0u);
      }
      const float lt = l_run + __shfl_xor(l_run, 32);
      const float gate = sigmoidf(br == 0 ? gt0 : (br == 1 ? gt1 : gt2));
      const float sc = lt > 0.f ? gate / lt : 0.f;
#pragma unroll
      for (int e = 0; e < 16; ++e) { tot[0][e] += oacc[0][e] * sc; tot[1][e] += oacc[1][e] * sc; }
    }
    if (!dry) store_y(tot, p.projZ + tok * LDA_Z + 768 + hd * 64);
  }
}

DI void phaseB3(const Params& p, int l) {
  const int lane = TIDX & 63, wid = TIDX >> 6;
  const float* g = p.b_out_norm + l * 128;
  const int d0 = (lane & 15) * 8;
  float gq[8];
#pragma unroll
  for (int i = 0; i < 8; ++i) gq[i] = g[d0 + i];
  const int tstep = gridDim.x * 4;
  int t = blockIdx.x * 4 + wid;
  uint4 nov = make_uint4(0, 0, 0, 0), nzv = make_uint4(0, 0, 0, 0);
  if (t < T_TOK) { nov = *(const uint4*)(p.ob + (size_t)t * 512 + lane * 8); nzv = *(const uint4*)(p.projZ + (size_t)t * LDA_Z + 256 + lane * 8); }
#pragma unroll 1
  for (; t < T_TOK; t += tstep) {
    const uint4 ov = nov, zv = nzv;
    const int tn = t + tstep < T_TOK ? t + tstep : t;
    nov = *(const uint4*)(p.ob + (size_t)tn * 512 + lane * 8); nzv = *(const uint4*)(p.projZ + (size_t)tn * LDA_Z + 256 + lane * 8);
    float v[8], z[8];
    v[0] = __uint_as_float(ov.x << 16); v[1] = __uint_as_float(ov.x & 0xffff0000u);
    v[2] = __uint_as_float(ov.y << 16); v[3] = __uint_as_float(ov.y & 0xffff0000u);
    v[4] = __uint_as_float(ov.z << 16); v[5] = __uint_as_float(ov.z & 0xffff0000u);
    v[6] = __uint_as_float(ov.w << 16); v[7] = __uint_as_float(ov.w & 0xffff0000u);
    z[0] = __uint_as_float(zv.x << 16); z[1] = __uint_as_float(zv.x & 0xffff0000u);
    z[2] = __uint_as_float(zv.y << 16); z[3] = __uint_as_float(zv.y & 0xffff0000u);
    z[4] = __uint_as_float(zv.z << 16); z[5] = __uint_as_float(zv.z & 0xffff0000u);
    z[6] = __uint_as_float(zv.w << 16); z[7] = __uint_as_float(zv.w & 0xffff0000u);
    float ss = 0.f;
#pragma unroll
    for (int i = 0; i < 8; ++i) ss += v[i] * v[i];
#pragma unroll
    for (int o = 8; o >= 1; o >>= 1) ss += __shfl_xor(ss, o);
    const float rr = rsqrtf(ss * (1.f / 128.f) + 1e-6f);
    float y[8];
#pragma unroll
    for (int i = 0; i < 8; ++i) y[i] = v[i] * rr * gq[i] * z[i];
    uint4 w; w.x = pack2(y[0], y[1]); w.y = pack2(y[2], y[3]); w.z = pack2(y[4], y[5]); w.w = pack2(y[6], y[7]);
    *(uint4*)(p.projZ + (size_t)t * LDA_Z + 256 + lane * 8) = w;
  }
}

DI void kvup_tile(const Params& p, int l, int mt, int tn, char* smem) {
  f32x16 acc[2][2];
  const int m0 = mt * 128;
  gemm_main<2>(acc, p.projA + 512, RowLin{LDA_A}, 64, m0, T_TOK, p.wt_ukv, 128, tn * 128, 2, smem);
  float* Ct = (float*)smem; float* rn = (float*)(smem + 128 * 132 * 4);
  acc_to_ct<2>(acc, Ct);
  const int b = m0 / SEQ, s0 = m0 % SEQ;
  if (tn < 2) {
    epi_rownorm(Ct, rn, 64);
    const float* g = p.a_k_norm + l * 64;
    epi_storeKF(Ct, 0, rn, 0, g, p.akv + (((size_t)b * 4 + tn * 2) * 64 + s0 / 32) * 2048);
    epi_storeKF(Ct, 64, rn, 1, g, p.akv + (((size_t)b * 4 + tn * 2 + 1) * 64 + s0 / 32) * 2048);
  } else {
    const int h0 = (tn - 2) * 2;
    epi_storeVF(Ct, 0, p.avT + (((size_t)b * 4 + h0) * 64 + s0 / 32) * 2048);
    epi_storeVF(Ct, 64, p.avT + (((size_t)b * 4 + h0 + 1) * 64 + s0 / 32) * 2048);
  }
  __syncthreads();
}

DI void cmp1_tile(const Params& p, int kv, int mt, int tn, char* smem) {
  f32x16 acc[2][2];
  const int m0 = mt * 128;
  gemm_main<2>(acc, p.projA, RowCmp{(size_t)(kv ? 1280 : 1216)}, LDA_A, m0, 2032, p.wt_phi1 + (size_t)kv * 256 * 2048, 2048, tn * 128, 32, smem);
  float* Ct = (float*)smem;
  acc_to_ct<2>(acc, Ct);
  bf16_t* dst = p.hid + (size_t)kv * 2048 * 256;
  epi_store64(Ct, 0, nullptr, 0, nullptr, true, p.posbias + kv * 256 + tn * 128, dst, 256, tn * 128, m0, 2032);
  epi_store64(Ct, 64, nullptr, 0, nullptr, true, p.posbias + kv * 256 + tn * 128 + 64, dst, 256, tn * 128 + 64, m0, 2032);
  __syncthreads();
}

DI void cmp2_tile(const Params& p, int l, int kv, int mt, char* smem) {
  f32x16 acc[2][2];
  const int m0 = mt * 128;
  gemm_main<2>(acc, p.hid + (size_t)kv * 2048 * 256, RowLin{256}, 64, m0, 2032, p.wt_phi2 + (size_t)kv * 128 * 256, 256, 0, 4, smem);
  float* Ct = (float*)smem; float* rn = (float*)(smem + 128 * 132 * 4);
  acc_to_ct<2>(acc, Ct);
  if (kv == 0) {
    epi_rownorm(Ct, rn, 64);
    const float* g = p.c_k_norm + (l * 3 + 0) * 64;
    for (int idx = TIDX; idx < 128 * 64; idx += 256) {
      const int row = idx >> 6, d = idx & 63, m = m0 + row;
      if (m >= 2032) continue;
      const int b = m / 127, n = m % 127;
      p.kc[((size_t)b * 4 + (n >> 5)) * 2048 + foff_nat(n & 31, d)] = f2bf(Ct[row * 132 + d] * rn[row * 2] * g[d]);
      if (n == 126) p.kc[((size_t)b * 4 + 3) * 2048 + foff_nat(31, d)] = 0;
    }
  } else {
    for (int idx = TIDX; idx < 128 * 64; idx += 256) {
      const int d = idx >> 7, row = idx & 127, m = m0 + row;
      if (m >= 2032) continue;
      const int b = m / 127, n = m % 127;
      p.vcT[((size_t)b * 4 + (n >> 5)) * 2048 + (d >> 5) * 1024 + foff_perm(d & 31, n & 31)] = f2bf(Ct[row * 132 + d]);
      if (n == 126) p.vcT[((size_t)b * 4 + 3) * 2048 + (d >> 5) * 1024 + foff_perm(d & 31, 31)] = 0;
    }
  }
  __syncthreads();
}

DI void merge_tile(const Params& p, int mt, int nt, char* smem) {
  f32x16 mac[2][1];
#pragma unroll
  for (int i = 0; i < 2; ++i)
#pragma unroll
    for (int e = 0; e < 16; ++e) mac[i][0][e] = 0.f;
  const int m0 = mt * 128, n0 = nt * 64;
#pragma unroll 1
  for (int x = 0; x < 3; ++x) {
    const int koff = x == 0 ? 0 : (x == 1 ? 256 : 768);
    const int nkp = x == 1 ? 8 : 4;
    f32x16 ag[2][1], ap[2][1];
    gemm_main<1>(ag, p.h, RowLin{1024}, 64, m0, T_TOK, p.wt_in + (size_t)(4224 + x * 1024) * 1024, 1024, n0, 16, smem);
    gemm_main<1>(ap, p.projZ + koff, RowLin{LDA_Z}, 64, m0, T_TOK, p.wt_br + koff, 1024, n0, nkp, smem);
#pragma unroll
    for (int i = 0; i < 2; ++i)
#pragma unroll
      for (int e = 0; e < 16; ++e) mac[i][0][e] += sigmoidf(ag[i][0][e]) * ap[i][0][e];
  }
  float* Ct = (float*)smem;
  acc_to_ct<1>(mac, Ct);
  epi_store64(Ct, 0, nullptr, 0, nullptr, false, nullptr, p.merged, 1024, n0, m0, T_TOK);
  __syncthreads();
}

DI void outproj_tile(const Params& p, int l, int mt, int tn, char* smem) {
  f32x16 acc[2][2];
  const int m0 = mt * 128;
  gemm_main<2>(acc, p.merged, RowLin{1024}, 64, m0, T_TOK, p.wt_out, 1024, tn * 128, 16, smem);
  float* Ct = (float*)smem;
  acc_to_ct<2>(acc, Ct);
  const float* xo = l == 0 ? p.x_in : p.out;
  {
    const int tid = TIDX, c = (tid & 31) * 4, row0 = tid >> 5;
    float4 xa[16];
#pragma unroll
    for (int q = 0; q < 16; ++q) xa[q] = *(const float4*)(xo + (size_t)(m0 + row0 + 8 * q) * 1024 + tn * 128 + c);
#pragma unroll
    for (int q = 0; q < 16; ++q) {
      const float4 cc = *(const float4*)(Ct + (row0 + 8 * q) * 132 + c);
      *(float4*)(p.out + (size_t)(m0 + row0 + 8 * q) * 1024 + tn * 128 + c) = make_float4(xa[q].x + cc.x, xa[q].y + cc.y, xa[q].z + cc.z, xa[q].w + cc.w);
    }
  }
  __syncthreads();
}

__global__ void __launch_bounds__(256, 2) mega(Params p, int ph_lo, int ph_hi) {
  __shared__ __attribute__((aligned(16))) char smem[SMEM_BYTES];
  cg::grid_group grid = cg::this_grid();
  for (int ph = ph_lo; ph < ph_hi; ++ph) {
    const int l = ph / NPH, s = ph % NPH;
    const int reps = ((DUP_MASK >> s) & 1) ? 2 : 1;
    for (int rep = 0; rep < reps; ++rep) {
    if (rep > 0) grid.sync();
    switch (s) {
      case 0: if (PHASE_ONLY >= 0 && PHASE_ONLY != 0) break; phase0(p, l, smem); break;
      case 1: if (PHASE_ONLY >= 0 && PHASE_ONLY != 1) break; phase_inproj(p, l, true, 0, smem); break;
      case 2: if (PHASE_ONLY >= 0 && PHASE_ONLY != 2) break; phaseB1(p, l, smem); break;
      case 3: if (PHASE_ONLY >= 0 && PHASE_ONLY != 3) break; {
        const int nb2 = gridDim.x >= 128 ? 64 : 0;
        if ((int)blockIdx.x < nb2) phaseB2(p, blockIdx.x, smem, 0, B2_S1);
        else phase_inproj(p, l, false, nb2, smem);
        if (nb2 == 0) for (int u = blockIdx.x; u < 64; u += gridDim.x) phaseB2(p, u, smem, 0, B2_S1);
      } break;
      case 4: if (PHASE_ONLY >= 0 && PHASE_ONLY != 4) break; {
        const int nb2 = gridDim.x >= 128 ? 64 : 0;
        if ((int)blockIdx.x < nb2) phaseB2(p, blockIdx.x, smem, B2_S1, B2_S2);
        else {
          for (int t = blockIdx.x - nb2; t < 64 + 1024; t += gridDim.x - nb2) {
            if (t < 64) cmp1_tile(p, t >> 5, (t >> 1) & 15, t & 1, smem);
            else { const int tt = t - 64; kvup_tile(p, l, tt >> 2, tt & 3, smem); }
          }
          const int va = (int)blockIdx.x - nb2 - 64, nva = (int)gridDim.x - nb2 - 64;
          if (nb2 && va >= 0 && nva > 0) phaseA1(p, va, nva, 0, A1_EARLY, smem);
        }
        if (nb2 == 0) for (int u = blockIdx.x; u < 64; u += gridDim.x) phaseB2(p, u, smem, B2_S1, B2_S2);
      } break;
      case 5: if (PHASE_ONLY >= 0 && PHASE_ONLY != 5) break; {
        const int nb2 = gridDim.x >= 128 ? 64 : 0;
        const int nvb = gridDim.x - nb2;
        const int ubeg = (nb2 && (int)gridDim.x - nb2 - 64 > 0) ? A1_EARLY : 0;
        const int usplit = nb2 ? ubeg + (4096 - ubeg - 3 * nb2) / nvb * nvb : 4096;
        if ((int)blockIdx.x < nb2) {
          phaseB2(p, blockIdx.x, smem, B2_S2, 32);
          phaseA1(p, blockIdx.x, nb2, usplit, 4096, smem);
        } else {
          for (int t = blockIdx.x - nb2; t < 32; t += nvb) cmp2_tile(p, l, t >> 4, t & 15, smem);
          phaseA1(p, blockIdx.x - nb2, nvb, ubeg, usplit, smem);
        }
        if (nb2 == 0) for (int u = blockIdx.x; u < 64; u += gridDim.x) phaseB2(p, u, smem, B2_S2, 32);
      } break;
      case 6: if (PHASE_ONLY >= 0 && PHASE_ONLY != 6) break; break;
      case 7: if (PHASE_ONLY >= 0 && PHASE_ONLY != 7) break; {
        float* lut = (float*)smem;
        setup_lut(p, lut);
#ifndef SKIP_C2A
        if (!(rep > 0 && PROBE7 == 2)) phaseC2a(p, lut);
#endif
#ifndef SKIP_A2
        if (!(rep > 0 && PROBE7 == 1)) phaseA2(p, lut, rep > 0);
#endif
        __syncthreads();
      } break;
      case 8: if (PHASE_ONLY >= 0 && PHASE_ONLY != 8) break; {
        float* lut = (float*)smem;
        setup_lut(p, lut);
        phaseC2b(p, lut, rep > 0);
        if (rep == 0) phaseB3(p, l);
        __syncthreads();
      } break;
      case 9: if (PHASE_ONLY >= 0 && PHASE_ONLY != 9) break; {
        for (int idx = blockIdx.x >> 3; idx < 512; idx += gridDim.x >> 3) { const int t = (blockIdx.x & 7) * 512 + idx; merge_tile(p, t >> 4, t & 15, smem); }
      } break;
      case 10: if (PHASE_ONLY >= 0 && PHASE_ONLY != 10) break; {
        for (int idx = blockIdx.x >> 3; idx < 256; idx += gridDim.x >> 3) { const int t = (blockIdx.x & 7) * 256 + idx; outproj_tile(p, l, t >> 3, t & 7, smem); }
      } break;
    }
    }
    if (ph + 1 < ph_hi && s != 5) grid.sync();
  }
}

extern "C" void kernel_launch(void* const* d_in, const int* in_sizes, int n_in, void* d_out, int out_size, void* d_ws,
                              size_t ws_size, hipStream_t stream) {
  Params p{};
  p.x_in = (const float*)d_in[0]; p.norm_g = (const float*)d_in[1]; p.w_in = (const float*)d_in[2];
  p.a_kv_norm = (const float*)d_in[3]; p.a_w_ukv = (const float*)d_in[4]; p.a_q_norm = (const float*)d_in[5];
  p.a_k_norm = (const float*)d_in[6]; p.b_conv = (const float*)d_in[7]; p.b_a_log = (const float*)d_in[8];
  p.b_dt_bias = (const float*)d_in[9]; p.b_out_norm = (const float*)d_in[10]; p.c_q_norm = (const float*)d_in[11];
  p.c_k_norm = (const float*)d_in[12]; p.c_cmp_pos = (const float*)d_in[13]; p.c_phi_w1 = (const float*)d_in[14];
  p.c_phi_w2 = (const float*)d_in[15]; p.w_branch = (const float*)d_in[16]; p.w_out = (const float*)d_in[17];
  p.rel_bias = (const float*)d_in[18];
  p.out = (float*)d_out;
  char* ws = (char*)d_ws; size_t off = 0;
  auto take = [&](size_t bytes) { char* q = ws + off; off += (bytes + 255) & ~(size_t)255; return q; };
  p.wt_in = (bf16_t*)take((size_t)7296 * 1024 * 2);
  p.wt_ukv = (bf16_t*)take((size_t)512 * 128 * 2);
  p.wt_phi1 = (bf16_t*)take((size_t)2 * 256 * 2048 * 2);
  p.wt_phi2 = (bf16_t*)take((size_t)2 * 128 * 256 * 2);
  p.wt_br = (bf16_t*)take((size_t)1024 * 1024 * 2);
  p.wt_out = (bf16_t*)take((size_t)1024 * 1024 * 2);
  p.posbias = (float*)take(2 * 256 * 4);
  p.h = (bf16_t*)take((size_t)T_TOK * 1024 * 2);
  char* X = take((size_t)T_TOK * (LDA_A + LDA_Z) * 2);
  p.projA = (bf16_t*)X; p.projZ = (bf16_t*)(X + (size_t)T_TOK * LDA_A * 2); p.projB = (bf16_t*)X;
  p.small = (float*)take((size_t)T_TOK * 32 * 4);
  p.akv = (bf16_t*)take((size_t)T_TOK * 256 * 2);
  p.avT = (bf16_t*)take((size_t)T_TOK * 256 * 2);
  p.vselT = (bf16_t*)take((size_t)T_TOK * 64 * 2);
  p.vwinT = (bf16_t*)take((size_t)T_TOK * 64 * 2);
  p.kselF = (bf16_t*)take((size_t)T_TOK * 64 * 2);
  p.kwinF = (bf16_t*)take((size_t)T_TOK * 64 * 2);
  p.kidxF = (bf16_t*)take((size_t)T_TOK * 64 * 2);
  p.hid = (bf16_t*)take((size_t)2 * 2048 * 256 * 2);
  p.kc = (bf16_t*)take((size_t)16 * 128 * 64 * 2);
  p.vcT = (bf16_t*)take((size_t)16 * 64 * 128 * 2);
  p.bm = (unsigned*)take((size_t)T_TOK * 64 * 4);
  p.selmask = (unsigned*)take((size_t)T_TOK * 4);
  char* BR = take((size_t)2048 * 8192 * 2 * 4);
  p.b_w = (bf16_t*)BR; p.b_qd = p.b_w + (size_t)2048 * 8192; p.b_kdT = p.b_qd + (size_t)2048 * 8192; p.b_uT = p.b_kdT + (size_t)2048 * 8192;
  p.merged = (bf16_t*)BR;
  p.b_attn = (bf16_t*)take((size_t)2048 * 4096 * 2);
  p.b_egl = (float*)take(2048 * 4);
  p.b_state = (float*)take((size_t)2 * 64 * 256 * 64 * 4);
  p.ob = (bf16_t*)take((size_t)T_TOK * 512 * 2);
  if (off > ws_size) { fprintf(stderr, "workspace too small: need %zu have %zu\n", off, ws_size); return; }

  static int grid_blocks = 0;
  if (!grid_blocks) {
    int dev = 0, cus = 0, per_cu = 0;
    hipGetDevice(&dev);
    hipDeviceGetAttribute(&cus, hipDeviceAttributeMultiprocessorCount, dev);
    hipOccupancyMaxActiveBlocksPerMultiprocessor(&per_cu, mega, 256, 0);
    if (per_cu < 1) per_cu = 1;
    grid_blocks = cus * per_cu;
  }
  int lo = 0, hi = 4 * NPH;
  void* args[] = {&p, &lo, &hi};
  hipError_t e = hipLaunchCooperativeKernel((void*)mega, dim3(grid_blocks), dim3(256), args, 0, stream);
  if (e != hipSuccess) fprintf(stderr, "cooperative launch failed: %s (grid %d)\n", hipGetErrorString(e), grid_blocks);
}
```

```cpp
#include <hip/hip_runtime.h>
#include <hip/hip_cooperative_groups.h>
#include <cstdio>
namespace cg = cooperative_groups;

typedef unsigned short bf16_t;
using bf16x8 = __attribute__((ext_vector_type(8))) short;
using f32x16 = __attribute__((ext_vector_type(16))) float;
#define DI __device__ __forceinline__
#define MFMA32(a, b, c) __builtin_amdgcn_mfma_f32_32x32x16_bf16((a), (b), (c), 0, 0, 0)

#ifndef PROBE7
#define PROBE7 0
#endif
#ifndef PROBE5
#define PROBE5 0
#endif
#ifndef DUP_MASK
#define DUP_MASK 0
#endif
#ifndef PHASE_ONLY
#define PHASE_ONLY -1
#endif
constexpr int T_TOK = 32768;
constexpr int SEQ = 2048;
constexpr int NPH = 11;
constexpr int B2_S1 = 19, B2_S2 = 23;
constexpr int A1_EARLY = 768;
constexpr int SMEM_BYTES = 73728;
constexpr int LDA_A = 1664;
constexpr int LDA_B = 1536;
constexpr int LDA_Z = 1024;

struct Params {
  const float* x_in; const float* norm_g; const float* w_in; const float* a_kv_norm; const float* a_w_ukv;
  const float* a_q_norm; const float* a_k_norm; const float* b_conv; const float* b_a_log; const float* b_dt_bias;
  const float* b_out_norm; const float* c_q_norm; const float* c_k_norm; const float* c_cmp_pos;
  const float* c_phi_w1; const float* c_phi_w2; const float* w_branch; const float* w_out; const float* rel_bias;
  float* out;
  bf16_t* wt_in; bf16_t* wt_ukv; bf16_t* wt_phi1; bf16_t* wt_phi2; bf16_t* wt_br; bf16_t* wt_out;
  float* posbias;
  bf16_t* h; bf16_t* projA; bf16_t* projB; bf16_t* projZ; float* small;
  bf16_t* akv; bf16_t* avT; bf16_t* vselT; bf16_t* vwinT; bf16_t* hid; bf16_t* kc; bf16_t* vcT; bf16_t* kselF; bf16_t* kwinF; bf16_t* kidxF;
  unsigned* bm; unsigned* selmask;
  float* b_state; bf16_t* b_w; bf16_t* b_qd; bf16_t* b_kdT; bf16_t* b_attn; bf16_t* b_uT; float* b_egl;
  bf16_t* ob; bf16_t* merged;
};

DI int tid_launder() { int t = threadIdx.x; asm volatile("" : "+v"(t)); return t; }
#define TIDX (tid_launder())
DI float bf2f(bf16_t b) { return __uint_as_float(((unsigned)b) << 16); }
typedef __bf16 hwbf2 __attribute__((ext_vector_type(2)));
typedef float hwf2 __attribute__((ext_vector_type(2)));
DI unsigned pack2(float a, float b) { hwf2 v = {a, b}; hwbf2 r = __builtin_convertvector(v, hwbf2); return __builtin_bit_cast(unsigned, r); }
DI bf16_t f2bf(float x) { return (bf16_t)(pack2(x, 0.f) & 0xffffu); }
DI int crow(int reg, int hh) { return (reg & 3) + 8 * (reg >> 2) + 4 * hh; }
DI float siluf(float x) { return x * __builtin_amdgcn_rcpf(1.f + __expf(-x)); }
DI float sigmoidf(float x) { return __builtin_amdgcn_rcpf(1.f + __expf(-x)); }
DI float wave_sum(float v) {
#pragma unroll
  for (int o = 32; o >= 1; o >>= 1) v += __shfl_xor(v, o);
  return v;
}
DI bf16x8 pack8(const f32x16& x, int s) {
  uint4 u;
  u.x = pack2(x[8 * s + 0], x[8 * s + 1]); u.y = pack2(x[8 * s + 2], x[8 * s + 3]);
  u.z = pack2(x[8 * s + 4], x[8 * s + 5]); u.w = pack2(x[8 * s + 6], x[8 * s + 7]);
  return __builtin_bit_cast(bf16x8, u);
}
DI bf16x8 ld_perm(const bf16_t* p, int hh) {
  uint2 lo = *(const uint2*)(p + 4 * hh);
  uint2 hi = *(const uint2*)(p + 8 + 4 * hh);
  uint4 u; u.x = lo.x; u.y = lo.y; u.z = hi.x; u.w = hi.y;
  return __builtin_bit_cast(bf16x8, u);
}
DI int foff_nat(int r, int k) { return (((k >> 4) * 2 + ((k >> 3) & 1)) * 32 + r) * 8 + (k & 7); }
DI int foff_perm(int r, int k) { const int kk = k & 15; return (((k >> 4) * 2 + ((kk >> 2) & 1)) * 32 + r) * 8 + (((kk >> 3) << 2) | (kk & 3)); }
DI bf16x8 ld16(const bf16_t* p) { return __builtin_bit_cast(bf16x8, *(const uint4*)p); }

DI int srccol(int j) {
  if (j < 256) return j;
  if (j < 512) return 3280 + (j - 256);
  if (j < 640) return 256 + (j - 512);
  if (j < 1152) return 384 + (j - 640);
  if (j < 1216) return 896 + (j - 1152);
  if (j < 1280) return 3536 + (j - 1216);
  if (j < 1344) return 3600 + (j - 1280);
  if (j < 1408) return 3664 + (j - 1344);
  if (j < 1472) return 3792 + (j - 1408);
  if (j < 1536) return 3728 + (j - 1472);
  if (j < 1600) return 3856 + (j - 1536);
  if (j < 1608) return 960 + (j - 1600);
  if (j < 1612) return 2760 + (j - 1608);
  if (j < 1616) return 2764 + (j - 1612);
  if (j < 1628) return 3920 + (j - 1616);
  if (j < 1664) return -1;
  if (j < 3200) return 1224 + (j - 1664);
  if (j < 3456) return 968 + (j - 3200);
  if (j < 3968) return 2768 + (j - 3456);
  if (j < 4224) return 3932 + (j - 3968);
  return 4188 + (j - 4224);
}

DI void tr_job(const float* __restrict__ src, int ld, int K, int Nsrc, bool map, bf16_t* __restrict__ dst, int Nrows,
               float* lds, int rot) {
  const int ntk = K / 64, ntiles = (Nrows / 64) * ntk;
  const int vb = (blockIdx.x + rot) % gridDim.x;
  const int tx = TIDX & 63, ty = TIDX >> 6;
  for (int t = vb; t < ntiles; t += gridDim.x) {
    const int j0 = (t / ntk) * 64, k0 = (t % ntk) * 64;
    const int j = j0 + tx;
    const int sc = map ? srccol(j) : (j < Nsrc ? j : -1);
    {
      float v[16];
      const int scc = sc >= 0 ? sc : 0;
#pragma unroll
      for (int q = 0; q < 16; ++q) v[q] = src[(size_t)(k0 + ty + 4 * q) * ld + scc];
#pragma unroll
      for (int q = 0; q < 16; ++q) lds[(ty + 4 * q) * 65 + tx] = sc >= 0 ? v[q] : 0.f;
    }
    __syncthreads();
    for (int jj = ty; jj < 64; jj += 4) dst[(size_t)(j0 + jj) * K + k0 + tx] = f2bf(lds[tx * 65 + jj]);
    __syncthreads();
  }
}

DI void phase0(const Params& p, int l, char* smem) {
  float* lds = (float*)smem;
  tr_job(p.w_in + (size_t)l * 1024 * 7260, 7260, 1024, 7260, true, p.wt_in, 7296, lds, 0);
  tr_job(p.a_w_ukv + (size_t)l * 128 * 512, 512, 128, 512, false, p.wt_ukv, 512, lds, 64);
  for (int kv = 0; kv < 2; ++kv) {
    tr_job(p.c_phi_w1 + ((size_t)l * 2 + kv) * 2048 * 256, 256, 2048, 256, false, p.wt_phi1 + (size_t)kv * 256 * 2048, 256, lds, 96 + kv * 128);
    tr_job(p.c_phi_w2 + ((size_t)l * 2 + kv) * 256 * 64, 64, 256, 64, false, p.wt_phi2 + (size_t)kv * 128 * 256, 128, lds, 80 + kv * 8);
  }
  tr_job(p.w_branch + (size_t)l * 1024 * 1024, 1024, 1024, 1024, false, p.wt_br, 1024, lds, 352);
  tr_job(p.w_out + (size_t)l * 1024 * 1024, 1024, 1024, 1024, false, p.wt_out, 1024, lds, 96);
  {
    const int vb = (blockIdx.x + 200) % gridDim.x;
    for (int j = vb; j < 16; j += gridDim.x) {
      const int kv = j >> 3, n = (j & 7) * 32 + (TIDX & 31), kg = TIDX >> 5;
      const float* pos = p.c_cmp_pos + ((size_t)l * 2 + kv) * 2048;
      const float* w1 = p.c_phi_w1 + ((size_t)l * 2 + kv) * 2048 * 256;
      float s = 0.f;
      for (int kk0 = kg * 256; kk0 < kg * 256 + 256; kk0 += 32) {
        float pv[32], wv[32];
#pragma unroll
        for (int j2 = 0; j2 < 32; ++j2) { pv[j2] = pos[kk0 + j2]; wv[j2] = w1[(size_t)(kk0 + j2) * 256 + n]; }
#pragma unroll
        for (int j2 = 0; j2 < 32; ++j2) s += pv[j2] * wv[j2];
      }
      lds[TIDX] = s;
      __syncthreads();
      if (TIDX < 32) {
        float tsum = 0.f;
        for (int g = 0; g < 8; ++g) tsum += lds[g * 32 + TIDX];
        p.posbias[kv * 256 + n] = tsum;
      }
      __syncthreads();
    }
  }
  {
    const float* x = l == 0 ? p.x_in : p.out;
    const float* g = p.norm_g + (size_t)l * 1024;
    const int lane = TIDX & 63, wave = TIDX >> 6;
    float4 gg[4];
#pragma unroll
    for (int i = 0; i < 4; ++i) gg[i] = ((const float4*)g)[lane + 64 * i];
    const int tstep = gridDim.x * 4;
    int t = blockIdx.x * 4 + wave;
    float4 v0, v1, v2, v3;
    if (t < T_TOK) { const float4* xr = (const float4*)(x + (size_t)t * 1024); v0 = xr[lane]; v1 = xr[lane + 64]; v2 = xr[lane + 128]; v3 = xr[lane + 192]; }
#pragma unroll 1
    for (; t < T_TOK; t += tstep) {
      const float4 c0 = v0, c1 = v1, c2 = v2, c3 = v3;
      const int tn = t + tstep < T_TOK ? t + tstep : t;
      { const float4* xr = (const float4*)(x + (size_t)tn * 1024); v0 = xr[lane]; v1 = xr[lane + 64]; v2 = xr[lane + 128]; v3 = xr[lane + 192]; }
      float ss = c0.x * c0.x + c0.y * c0.y + c0.z * c0.z + c0.w * c0.w + c1.x * c1.x + c1.y * c1.y + c1.z * c1.z + c1.w * c1.w
               + c2.x * c2.x + c2.y * c2.y + c2.z * c2.z + c2.w * c2.w + c3.x * c3.x + c3.y * c3.y + c3.z * c3.z + c3.w * c3.w;
      ss = wave_sum(ss);
      const float r = rsqrtf(ss * (1.f / 1024.f) + 1e-6f);
      bf16_t* hr = p.h + (size_t)t * 1024 + lane * 4;
      uint2 o;
      o.x = pack2(c0.x * r * gg[0].x, c0.y * r * gg[0].y); o.y = pack2(c0.z * r * gg[0].z, c0.w * r * gg[0].w); *(uint2*)(hr) = o;
      o.x = pack2(c1.x * r * gg[1].x, c1.y * r * gg[1].y); o.y = pack2(c1.z * r * gg[1].z, c1.w * r * gg[1].w); *(uint2*)(hr + 256) = o;
      o.x = pack2(c2.x * r * gg[2].x, c2.y * r * gg[2].y); o.y = pack2(c2.z * r * gg[2].z, c2.w * r * gg[2].w); *(uint2*)(hr + 512) = o;
      o.x = pack2(c3.x * r * gg[3].x, c3.y * r * gg[3].y); o.y = pack2(c3.z * r * gg[3].z, c3.w * r * gg[3].w); *(uint2*)(hr + 768) = o;
    }
  }
}

struct RowLin { size_t ld; DI size_t operator()(int m) const { return (size_t)m * ld; } };
struct RowCmp { size_t col0; DI size_t operator()(int m) const { return ((size_t)(m / 127) * 2048 + (size_t)(m % 127) * 16) * LDA_A + col0; } };

template <int NJ, class RowA>
DI void gemm_main(f32x16 (&acc)[2][NJ], const bf16_t* __restrict__ A, RowA rowA, size_t kstrideA, int m0, int Mmax,
                  const bf16_t* __restrict__ Bt, size_t ldb, int n0, int nk, char* smem) {
  constexpr int BROWS = 64 * NJ;
  constexpr int NBCH = BROWS * 8 / 256;
  constexpr int STAGE = (128 + BROWS) * 144;
  const int tid = TIDX, lane = tid & 63, wid = tid >> 6, wm = wid >> 1, wn = wid & 1;
  const int r = lane & 31, hh = lane >> 5;
  const bf16_t* ap[4]; const bf16_t* bp[NBCH]; int alo[4], blo[NBCH];
#pragma unroll
  for (int i = 0; i < 4; ++i) {
    const int c = tid + 256 * i, row = c >> 3, kc = c & 7;
    int m = m0 + row; m = m < Mmax ? m : Mmax - 1;
    ap[i] = A + rowA(m) + kc * 8; alo[i] = row * 144 + kc * 16;
  }
#pragma unroll
  for (int i = 0; i < NBCH; ++i) {
    const int c = tid + 256 * i, row = c >> 3, kc = c & 7;
    bp[i] = Bt + (size_t)(n0 + row) * ldb + kc * 8; blo[i] = 128 * 144 + row * 144 + kc * 16;
  }
#pragma unroll
  for (int i = 0; i < 2; ++i)
#pragma unroll
    for (int j = 0; j < NJ; ++j)
#pragma unroll
      for (int e = 0; e < 16; ++e) acc[i][j][e] = 0.f;
  uint4 x0a0, x0a1, x0a2, x0a3, x0b0, x0b1, x0b2, x0b3, x1a0, x1a1, x1a2, x1a3, x1b0, x1b1, x1b2, x1b3;
  x0b2 = x0b3 = x1b2 = x1b3 = make_uint4(0, 0, 0, 0);
#define G_LOAD(S, unused, KT) do { const size_t ko_ = (size_t)(KT); \
    S##a0 = *(const uint4*)(ap[0] + ko_ * kstrideA); S##a1 = *(const uint4*)(ap[1] + ko_ * kstrideA); \
    S##a2 = *(const uint4*)(ap[2] + ko_ * kstrideA); S##a3 = *(const uint4*)(ap[3] + ko_ * kstrideA); \
    S##b0 = *(const uint4*)(bp[0] + ko_ * 64); S##b1 = *(const uint4*)(bp[1] + ko_ * 64); \
    if (NBCH == 4) { S##b2 = *(const uint4*)(bp[NBCH - 2] + ko_ * 64); S##b3 = *(const uint4*)(bp[NBCH - 1] + ko_ * 64); } } while (0)
#define G_STORE(ST, S, unused) do { char* d_ = smem + (ST) * STAGE; \
    *(uint4*)(d_ + alo[0]) = S##a0; *(uint4*)(d_ + alo[1]) = S##a1; *(uint4*)(d_ + alo[2]) = S##a2; *(uint4*)(d_ + alo[3]) = S##a3; \
    *(uint4*)(d_ + blo[0]) = S##b0; *(uint4*)(d_ + blo[1]) = S##b1; \
    if (NBCH == 4) { *(uint4*)(d_ + blo[NBCH - 2]) = S##b2; *(uint4*)(d_ + blo[NBCH - 1]) = S##b3; } } while (0)
#define G_COMPUTE(ST) do { const char* sA = smem + (ST) * STAGE; const char* sB = sA + 128 * 144; \
    __builtin_amdgcn_s_setprio(1); \
    _Pragma("unroll") for (int ks = 0; ks < 4; ++ks) { \
      bf16x8 a_[2], b_[NJ]; \
      _Pragma("unroll") for (int i = 0; i < 2; ++i) a_[i] = *(const bf16x8*)(sA + (wm * 64 + i * 32 + r) * 144 + ks * 32 + hh * 16); \
      _Pragma("unroll") for (int j = 0; j < NJ; ++j) b_[j] = *(const bf16x8*)(sB + (wn * 32 * NJ + j * 32 + r) * 144 + ks * 32 + hh * 16); \
      _Pragma("unroll") for (int i = 0; i < 2; ++i) \
        _Pragma("unroll") for (int j = 0; j < NJ; ++j) acc[i][j] = MFMA32(a_[i], b_[j], acc[i][j]); \
    } __builtin_amdgcn_s_setprio(0); } while (0)
  __syncthreads();
  G_LOAD(x0, 0, 0);
  G_LOAD(x1, 0, 1);
  G_STORE(0, x0, 0);
  __syncthreads();
#pragma unroll 1
  for (int kt = 0; kt < nk; kt += 2) {
    G_LOAD(x0, 0, (kt + 2 < nk ? kt + 2 : nk - 1));
    G_COMPUTE(0);
    G_STORE(1, x1, 0);
    __syncthreads();
    G_LOAD(x1, 0, (kt + 3 < nk ? kt + 3 : nk - 1));
    G_COMPUTE(1);
    G_STORE(0, x0, 0);
    __syncthreads();
  }
#undef G_LOAD
#undef G_STORE
#undef G_COMPUTE
}

template <int NJ>
DI void acc_to_ct(const f32x16 (&acc)[2][NJ], float* Ct) {
  const int lane = TIDX & 63, wid = TIDX >> 6, wm = wid >> 1, wn = wid & 1;
  const int r = lane & 31, hh = lane >> 5;
#pragma unroll
  for (int i = 0; i < 2; ++i)
#pragma unroll
    for (int j = 0; j < NJ; ++j)
#pragma unroll
      for (int e = 0; e < 16; ++e) Ct[(wm * 64 + i * 32 + crow(e, hh)) * 132 + wn * 32 * NJ + j * 32 + r] = acc[i][j][e];
  __syncthreads();
}

DI void epi_rownorm(const float* Ct, float* rn, int W) {
  const int row = TIDX >> 1, grp = TIDX & 1;
  float ss = 0.f;
  for (int c0 = 0; c0 < 64; ++c0) { const int c = (c0 + row) & 63; const float v = Ct[row * 132 + grp * 64 + c]; ss += v * v; }
  if (W == 128) { ss += __shfl_xor(ss, 1); ss *= 0.5f; }
  rn[row * 2 + grp] = rsqrtf(ss * (1.f / 64.f) + 1e-6f);
  __syncthreads();
}
DI void epi_store64(const float* Ct, int cb, const float* rn, int grp, const float* gain, bool silu, const float* bias,
                    bf16_t* dst, size_t ldd, int dcol0, int m0, int Mmax) {
  const int tid = TIDX, c = (tid & 15) * 4;
  float4 gv = make_float4(1.f, 1.f, 1.f, 1.f), bv = make_float4(0.f, 0.f, 0.f, 0.f);
  if (rn) gv = *(const float4*)(gain + c);
  if (bias) bv = *(const float4*)(bias + c);
#pragma unroll
  for (int q = 0; q < 8; ++q) {
    const int row = (tid >> 4) + 16 * q;
    float4 v = *(const float4*)(Ct + row * 132 + cb + c);
    v.x += bv.x; v.y += bv.y; v.z += bv.z; v.w += bv.w;
    if (rn) { const float sc = rn[row * 2 + grp]; v.x *= sc * gv.x; v.y *= sc * gv.y; v.z *= sc * gv.z; v.w *= sc * gv.w; }
    if (silu) { v.x = siluf(v.x); v.y = siluf(v.y); v.z = siluf(v.z); v.w = siluf(v.w); }
    uint2 o; o.x = pack2(v.x, v.y); o.y = pack2(v.z, v.w);
    *(uint2*)(dst + (size_t)(m0 + row) * ldd + dcol0 + c) = o;
  }
}
DI void epi_storeT(const float* Ct, int cb, bf16_t* dstT, size_t ldT, int s0) {
  for (int idx = TIDX; idx < 64 * 128; idx += 256) {
    const int d = idx >> 7, tk = idx & 127;
    dstT[(size_t)d * ldT + s0 + tk] = f2bf(Ct[tk * 132 + cb + d]);
  }
}

DI void epi_storeKF(const float* Ct, int cb, const float* rn, int grp, const float* gain, bf16_t* dst) {
  const int slot = TIDX, r = slot & 31, d0 = (slot >> 5) * 8;
  float gq[8];
#pragma unroll
  for (int j = 0; j < 8; ++j) gq[j] = rn ? gain[d0 + j] : 1.f;
#pragma unroll
  for (int kt4 = 0; kt4 < 4; ++kt4) {
    const int row = kt4 * 32 + r;
    float v[8];
    {
      const float4 va = *(const float4*)(Ct + row * 132 + cb + d0), vb = *(const float4*)(Ct + row * 132 + cb + d0 + 4);
      v[0] = va.x; v[1] = va.y; v[2] = va.z; v[3] = va.w; v[4] = vb.x; v[5] = vb.y; v[6] = vb.z; v[7] = vb.w;
    }
    if (rn) { const float sc = rn[row * 2 + grp];
#pragma unroll
      for (int j = 0; j < 8; ++j) v[j] *= sc * gq[j]; }
    uint4 o; o.x = pack2(v[0], v[1]); o.y = pack2(v[2], v[3]); o.z = pack2(v[4], v[5]); o.w = pack2(v[6], v[7]);
    *(uint4*)(dst + kt4 * 2048 + slot * 8) = o;
  }
}
DI void epi_storeVF(const float* Ct, int cb, bf16_t* dst) {
  for (int idx = TIDX; idx < 1024; idx += 256) {
    const int kt4 = idx >> 8, slot = idx & 255, r = slot & 31, hh = (slot >> 5) & 1, s2 = (slot >> 6) & 1, dt = slot >> 7;
    float v[8];
#pragma unroll
    for (int j = 0; j < 8; ++j) {
      const int key = 16 * s2 + 8 * (j >> 2) + 4 * hh + (j & 3);
      v[j] = Ct[(kt4 * 32 + key) * 132 + cb + dt * 32 + r];
    }
    uint4 o; o.x = pack2(v[0], v[1]); o.y = pack2(v[2], v[3]); o.z = pack2(v[4], v[5]); o.w = pack2(v[6], v[7]);
    *(uint4*)(dst + kt4 * 2048 + slot * 8) = o;
  }
}

DI void inproj_tile(const Params& p, int l, int mt, int tn, char* smem) {
  f32x16 acc[2][2];
  const int m0 = mt * 128;
  gemm_main<2>(acc, p.h, RowLin{1024}, 64, m0, T_TOK, p.wt_in, 1024, tn * 128, 16, smem);
  float* Ct = (float*)smem; float* rn = (float*)(smem + 128 * 132 * 4);
  acc_to_ct<2>(acc, Ct);
  const int b = m0 / SEQ, s0 = m0 % SEQ;
  if (tn <= 3) {
    epi_rownorm(Ct, rn, 64);
    const float* g = tn < 2 ? p.a_q_norm + l * 64 : p.c_q_norm + l * 64;
    epi_store64(Ct, 0, rn, 0, g, false, nullptr, p.projA, LDA_A, tn * 128, m0, T_TOK);
    epi_store64(Ct, 64, rn, 1, g, false, nullptr, p.projA, LDA_A, tn * 128 + 64, m0, T_TOK);
  } else if (tn == 4) {
    epi_rownorm(Ct, rn, 128);
    const float* g = p.a_kv_norm + l * 128;
    epi_store64(Ct, 0, rn, 0, g, false, nullptr, p.projA, LDA_A, 512, m0, T_TOK);
    epi_store64(Ct, 64, rn, 1, g + 64, false, nullptr, p.projA, LDA_A, 576, m0, T_TOK);
  } else if (tn <= 8) {
    epi_store64(Ct, 0, nullptr, 0, nullptr, false, nullptr, p.projA, LDA_A, tn * 128, m0, T_TOK);
    epi_store64(Ct, 64, nullptr, 0, nullptr, false, nullptr, p.projA, LDA_A, tn * 128 + 64, m0, T_TOK);
  } else if (tn == 9) {
    epi_storeKF(Ct, 0, nullptr, 0, nullptr, p.kidxF + ((size_t)b * 64 + s0 / 32) * 2048);
    epi_store64(Ct, 64, nullptr, 0, nullptr, false, nullptr, p.projA, LDA_A, tn * 128 + 64, m0, T_TOK);
  } else if (tn == 10) {
    epi_rownorm(Ct, rn, 64);
    epi_store64(Ct, 0, nullptr, 0, nullptr, false, nullptr, p.projA, LDA_A, 1280, m0, T_TOK);
    epi_storeKF(Ct, 64, rn, 1, p.c_k_norm + (l * 3 + 1) * 64, p.kselF + ((size_t)b * 64 + s0 / 32) * 2048);
  } else if (tn == 11) {
    epi_rownorm(Ct, rn, 64);
    epi_storeKF(Ct, 0, rn, 0, p.c_k_norm + (l * 3 + 2) * 64, p.kwinF + ((size_t)b * 64 + s0 / 32) * 2048);
    epi_storeVF(Ct, 64, p.vselT + ((size_t)b * 64 + s0 / 32) * 2048);
  } else if (tn == 12) {
    epi_storeVF(Ct, 0, p.vwinT + ((size_t)b * 64 + s0 / 32) * 2048);
    for (int idx = TIDX; idx < 128 * 32; idx += 256) {
      const int row = idx >> 5, c = idx & 31;
      p.small[(size_t)(m0 + row) * 32 + c] = Ct[row * 132 + 64 + c];
    }
  } else if (tn <= 24) {
    const int c0 = (tn - 13) * 128;
    epi_store64(Ct, 0, nullptr, 0, nullptr, false, nullptr, p.projB, LDA_B, c0, m0, T_TOK);
    epi_store64(Ct, 64, nullptr, 0, nullptr, false, nullptr, p.projB, LDA_B, c0 + 64, m0, T_TOK);
  } else {
    const int c0 = (tn - 25) * 128;
    epi_store64(Ct, 0, nullptr, 0, nullptr, true, nullptr, p.projZ, LDA_Z, c0, m0, T_TOK);
    epi_store64(Ct, 64, nullptr, 0, nullptr, true, nullptr, p.projZ, LDA_Z, c0 + 64, m0, T_TOK);
  }
  __syncthreads();
}

DI void phase_inproj(const Params& p, int l, bool partB, int skipb, char* smem) {
  const int ntn = partB ? 13 : 20;
  const int ntiles = 256 * ntn;
  const int per = ntiles >> 3;
  const int vblk = blockIdx.x - skipb, nvb = gridDim.x - skipb;
  for (int idx = vblk >> 3; idx < per; idx += nvb >> 3) {
    const int t = (vblk & 7) * per + idx;
    const int mt = t / ntn; int tn = t % ntn;
    if (partB) tn += 12; else if (tn >= 12) tn += 13;
    inproj_tile(p, l, mt, tn, smem);
  }
}

DI void phaseB1(const Params& p, int l, char* smem) {
  float* qs = (float*)smem;
  float* ks = qs + 64 * 132;
  float* sm = ks + 64 * 132;
  float* gcum = sm; float* beta = sm + 64; float* eg = sm + 128; float* rq = sm + 192; float* rk = sm + 256;
  float* Am = qs;
  const int tid = TIDX, lane = tid & 63;
  const float* convw = p.b_conv + (size_t)l * 4 * 1536;
  for (int u = blockIdx.x; u < 2048; u += gridDim.x) {
    const int b = u >> 7, n = (u >> 2) & 31, hd = u & 3;
    const int tok0 = b * SEQ + n * 64;
    {
      const int cg = tid & 31, which = cg >> 4, c0 = (cg & 15) * 8;
      const int ch = which * 512 + hd * 128 + c0;
      float wv[4][8];
#pragma unroll
      for (int j = 0; j < 4; ++j) {
        const float4 wa = *(const float4*)(convw + j * 1536 + ch), wb = *(const float4*)(convw + j * 1536 + ch + 4);
        wv[j][0] = wa.x; wv[j][1] = wa.y; wv[j][2] = wa.z; wv[j][3] = wa.w; wv[j][4] = wb.x; wv[j][5] = wb.y; wv[j][6] = wb.z; wv[j][7] = wb.w;
      }
      float* dstl = which ? ks : qs;
      uint4 rw[8][4];
#pragma unroll
      for (int i8 = 0; i8 < 8; ++i8) {
        const int i = (tid >> 5) + 8 * i8;
#pragma unroll
        for (int j = 0; j < 4; ++j) {
          const int row = i - 3 + j;
          const bool valid = (n > 0) || (row >= 0);
          const bf16_t* src = p.projB + (size_t)(tok0 + (valid ? row : 0)) * LDA_B + ch;
          rw[i8][j] = valid ? *(const uint4*)src : make_uint4(0, 0, 0, 0);
        }
      }
#pragma unroll
      for (int i8 = 0; i8 < 8; ++i8) {
        const int i = (tid >> 5) + 8 * i8;
        float acc[8];
#pragma unroll
        for (int e = 0; e < 8; ++e) acc[e] = 0.f;
#pragma unroll
        for (int j = 0; j < 4; ++j) {
          const uint4 v = rw[i8][j];
          acc[0] += wv[j][0] * __uint_as_float(v.x << 16); acc[1] += wv[j][1] * __uint_as_float(v.x & 0xffff0000u);
          acc[2] += wv[j][2] * __uint_as_float(v.y << 16); acc[3] += wv[j][3] * __uint_as_float(v.y & 0xffff0000u);
          acc[4] += wv[j][4] * __uint_as_float(v.z << 16); acc[5] += wv[j][5] * __uint_as_float(v.z & 0xffff0000u);
          acc[6] += wv[j][6] * __uint_as_float(v.w << 16); acc[7] += wv[j][7] * __uint_as_float(v.w & 0xffff0000u);
        }
        *(float4*)(dstl + i * 132 + c0) = make_float4(siluf(acc[0]), siluf(acc[1]), siluf(acc[2]), siluf(acc[3]));
        *(float4*)(dstl + i * 132 + c0 + 4) = make_float4(siluf(acc[4]), siluf(acc[5]), siluf(acc[6]), siluf(acc[7]));
      }
    }
    __syncthreads();
    if (tid < 128) {
      const int row = tid & 63, which = tid >> 6;
      const float* src = which ? ks : qs;
      float ss = 0.f;
      for (int c0 = 0; c0 < 128; ++c0) { const int c = (c0 + row) & 127; const float v = src[row * 132 + c]; ss += v * v; }
      float rr = rsqrtf(ss + 1e-6f);
      if (which) rk[row] = rr; else rq[row] = rr * 0.08838834764831845f;
    } else if (tid < 192) {
      const int i = tid - 128;
      const float a = p.small[(size_t)(tok0 + i) * 32 + 8 + hd];
      const float bb = p.small[(size_t)(tok0 + i) * 32 + 12 + hd];
      const float xx = a + p.b_dt_bias[l * 4 + hd];
      const float ex = __expf(xx);
      const float sp = xx > 20.f ? xx : (ex < 0.01f ? ex * (1.f - ex * (0.5f - ex * (1.f / 3.f))) : __logf(1.f + ex));
      float g = -__expf(p.b_a_log[l * 4 + hd]) * sp;
#pragma unroll
      for (int o = 1; o < 64; o <<= 1) { const float v = __shfl_up(g, o); if (lane >= o) g += v; }
      gcum[i] = g; beta[i] = sigmoidf(bb); eg[i] = __expf(g);
    }
    __syncthreads();
    for (int idx = tid; idx < 64 * 128; idx += 256) {
      const int i = idx >> 7, c = idx & 127;
      qs[i * 132 + c] *= rq[i]; ks[i * 132 + c] *= rk[i];
    }
    __syncthreads();
    f32x16 accK, accQ;
    const int w3 = tid >> 6, r3 = tid & 31, h3 = (tid >> 5) & 1;
    const int it3 = w3 == 0 ? 0 : 1, jt3 = w3 == 2 ? 1 : 0;
    {
#pragma unroll
      for (int e = 0; e < 16; ++e) { accK[e] = 0.f; accQ[e] = 0.f; }
      if (w3 < 3) {
#pragma unroll
        for (int kk = 0; kk < 8; ++kk) {
          const float* pk_i = ks + (it3 * 32 + r3) * 132 + kk * 16 + h3 * 8;
          const float* pq_i = qs + (it3 * 32 + r3) * 132 + kk * 16 + h3 * 8;
          const float* pk_j = ks + (jt3 * 32 + r3) * 132 + kk * 16 + h3 * 8;
          const float4 a0 = *(const float4*)pk_i, a1 = *(const float4*)(pk_i + 4);
          const float4 q0 = *(const float4*)pq_i, q1 = *(const float4*)(pq_i + 4);
          const float4 b0 = *(const float4*)pk_j, b1 = *(const float4*)(pk_j + 4);
          uint4 ua, uq, ub;
          ua.x = pack2(a0.x, a0.y); ua.y = pack2(a0.z, a0.w); ua.z = pack2(a1.x, a1.y); ua.w = pack2(a1.z, a1.w);
          uq.x = pack2(q0.x, q0.y); uq.y = pack2(q0.z, q0.w); uq.z = pack2(q1.x, q1.y); uq.w = pack2(q1.z, q1.w);
          ub.x = pack2(b0.x, b0.y); ub.y = pack2(b0.z, b0.w); ub.z = pack2(b1.x, b1.y); ub.w = pack2(b1.z, b1.w);
          const bf16x8 fb = __builtin_bit_cast(bf16x8, ub);
          accK = MFMA32(__builtin_bit_cast(bf16x8, ua), fb, accK);
          accQ = MFMA32(__builtin_bit_cast(bf16x8, uq), fb, accQ);
        }
      }
      bf16_t* attn_g = p.b_attn + (size_t)u * 4096;
      const int itw = w3 < 3 ? it3 : 0, jtw = w3 < 3 ? jt3 : 1;
      const int j = jtw * 32 + r3;
      const float gj = gcum[j];
#pragma unroll
      for (int e = 0; e < 16; ++e) {
        const int ri = crow(e, h3), i = itw * 32 + ri;
        const float dec = i >= j ? __expf(gcum[i] - gj) : 0.f;
        accK[e] = i > j ? beta[i] * accK[e] * dec : 0.f;
        const float at = (w3 < 3 && i >= j) ? accQ[e] * dec : 0.f;
        attn_g[itw * 2048 + foff_perm(ri, j)] = f2bf(at);
      }
    }
    {
      bf16_t* qd = p.b_qd + (size_t)u * 8192;
      for (int idx = tid; idx < 64 * 64; idx += 256) {
        const int i = idx >> 6, c = (idx & 63) * 2;
        *(unsigned*)(qd + (i >> 5) * 4096 + foff_perm(i & 31, c)) = pack2(qs[i * 132 + c] * eg[i], qs[i * 132 + c + 1] * eg[i]);
      }
      bf16_t* kdT = p.b_kdT + (size_t)u * 8192;
      const float gl = gcum[63];
      for (int idx = tid; idx < 128 * 16; idx += 256) {
        const int k = idx & 127, i0 = (idx >> 7) * 4;
        uint2 o;
        o.x = pack2(ks[i0 * 132 + k] * __expf(gl - gcum[i0]), ks[(i0 + 1) * 132 + k] * __expf(gl - gcum[i0 + 1]));
        o.y = pack2(ks[(i0 + 2) * 132 + k] * __expf(gl - gcum[i0 + 2]), ks[(i0 + 3) * 132 + k] * __expf(gl - gcum[i0 + 3]));
        *(uint2*)(kdT + (k >> 5) * 2048 + foff_perm(k & 31, i0)) = o;
      }
      if (tid == 0) p.b_egl[u] = eg[63];
    }
    __syncthreads();
    if (w3 < 3) {
      const int j = jt3 * 32 + r3;
#pragma unroll
      for (int e = 0; e < 16; ++e) Am[(it3 * 32 + crow(e, h3)) * 68 + j] = accK[e];
    }
    __syncthreads();
    {
      float x[64];
      if (tid < 128) {
        const int ch = 1024 + hd * 128 + tid;
        const float w0 = convw[ch], w1 = convw[1536 + ch], w2 = convw[2 * 1536 + ch], w3 = convw[3 * 1536 + ch];
        const bf16_t* src = p.projB + (size_t)tok0 * LDA_B + ch;
        float x0 = 0.f, x1 = 0.f, x2 = 0.f;
        if (n > 0) { x0 = bf2f(src[-3 * LDA_B]); x1 = bf2f(src[-2 * LDA_B]); x2 = bf2f(src[-1 * LDA_B]); }
#pragma unroll
        for (int i = 0; i < 64; ++i) x[i] = bf2f(src[(size_t)i * LDA_B]);
        __builtin_amdgcn_sched_barrier(0);
#pragma unroll
        for (int i = 0; i < 64; ++i) {
          const float x3 = x[i];
          x[i] = siluf(w0 * x0 + w1 * x1 + w2 * x2 + w3 * x3) * beta[i];
          x0 = x1; x1 = x2; x2 = x3;
        }
      } else {
        const int c = tid - 128;
#pragma unroll
        for (int i = 0; i < 64; ++i) x[i] = ks[i * 132 + c] * beta[i] * eg[i];
      }
#pragma unroll
      for (int i = 1; i < 64; ++i) {
        float s0 = 0.f, s1 = 0.f, s2 = 0.f, s3 = 0.f;
#pragma unroll
        for (int j4 = 0; j4 < i; j4 += 4) {
          const float4 a = *(const float4*)(Am + i * 68 + j4);
          s0 += a.x * x[j4];
          if (j4 + 1 < i) s1 += a.y * x[j4 + 1];
          if (j4 + 2 < i) s2 += a.z * x[j4 + 2];
          if (j4 + 3 < i) s3 += a.w * x[j4 + 3];
        }
        x[i] = x[i] - ((s0 + s1) + (s2 + s3));
      }
      if (tid < 128) {
        bf16_t* uT = p.b_uT + (size_t)u * 8192 + (tid >> 5) * 2048 + (tid & 31) * 4;
#pragma unroll
        for (int i4 = 0; i4 < 16; ++i4) {
          uint2 o; o.x = pack2(x[4 * i4], x[4 * i4 + 1]); o.y = pack2(x[4 * i4 + 2], x[4 * i4 + 3]);
          *(uint2*)(uT + i4 * 128) = o;
        }
      } else {
        bf16_t* w = p.b_w + (size_t)u * 8192 + foff_perm(0, tid - 128);
#pragma unroll
        for (int i = 0; i < 64; ++i) w[(i >> 5) * 4096 + (i & 31) * 8] = f2bf(x[i]);
      }
    }
    __syncthreads();
  }
}

DI void phaseB2(const Params& p, int bh, char* smem, int n_begin, int n_end) {
  const int tid = TIDX, lane = tid & 63, wid = tid >> 6, r = lane & 31, hh = lane >> 5;
  const int b = bh >> 2, hd = bh & 3, v0 = wid * 32;
  bf16_t* L = (bf16_t*)smem;
  const bf16_t* wg = L; const bf16_t* qg = L + 8192; const bf16_t* kg = L + 16384; const bf16_t* ag = L + 24576;
  const int lo8 = (hh * 32 + r) * 8;
  f32x16 S[4];
  const float* sst_in = p.b_state + ((size_t)(n_begin == B2_S1 ? 0 : 64) * 256 + (size_t)bh * 256 + tid) * 64;
  float* sst = p.b_state + ((size_t)(n_end == B2_S1 ? 0 : 64) * 256 + (size_t)bh * 256 + tid) * 64;
  if (n_begin == 0) {
#pragma unroll
    for (int T = 0; T < 4; ++T)
#pragma unroll
      for (int e = 0; e < 16; ++e) S[T][e] = 0.f;
  } else {
#pragma unroll
    for (int T = 0; T < 4; ++T)
#pragma unroll
      for (int q4 = 0; q4 < 4; ++q4) {
        const float4 v = *(const float4*)(sst_in + T * 16 + q4 * 4);
        S[T][q4 * 4] = v.x; S[T][q4 * 4 + 1] = v.y; S[T][q4 * 4 + 2] = v.z; S[T][q4 * 4 + 3] = v.w;
      }
  }
  const float eglv = p.b_egl[(b * 32 + (lane & 31)) * 4 + hd];
  uint4 pw0, pw1, pw2, pw3, pq0, pq1, pq2, pq3, pk0, pk1, pk2, pk3, pa0, pa1;
  uint2 pu0, pu1, pu2, pu3, pu4, pu5, pu6, pu7;
#define B2_LOAD(N) do { const size_t c_ = (size_t)((b * 32 + (N)) * 4 + hd); \
    const uint4* w_ = (const uint4*)(p.b_w + c_ * 8192) + tid; const uint4* q_ = (const uint4*)(p.b_qd + c_ * 8192) + tid; \
    const uint4* k_ = (const uint4*)(p.b_kdT + c_ * 8192) + tid; const uint4* a_ = (const uint4*)(p.b_attn + c_ * 4096) + tid; \
    pw0 = w_[0]; pw1 = w_[256]; pw2 = w_[512]; pw3 = w_[768]; pq0 = q_[0]; pq1 = q_[256]; pq2 = q_[512]; pq3 = q_[768]; \
    pk0 = k_[0]; pk1 = k_[256]; pk2 = k_[512]; pk3 = k_[768]; pa0 = a_[0]; pa1 = a_[256]; \
    } while (0)
#define B2_LOADU(N) do { const size_t c_ = (size_t)((b * 32 + (N)) * 4 + hd); \
    const bf16_t* u_ = p.b_uT + c_ * 8192 + (v0 >> 5) * 2048 + (hh * 32 + r) * 4; \
    pu0 = *(const uint2*)(u_); pu1 = *(const uint2*)(u_ + 256); pu2 = *(const uint2*)(u_ + 512); pu3 = *(const uint2*)(u_ + 768); \
    pu4 = *(const uint2*)(u_ + 1024); pu5 = *(const uint2*)(u_ + 1280); pu6 = *(const uint2*)(u_ + 1536); pu7 = *(const uint2*)(u_ + 1792); } while (0)
#define B2_STORE() do { uint4* l_ = (uint4*)L + tid; \
    l_[0] = pw0; l_[256] = pw1; l_[512] = pw2; l_[768] = pw3; l_[1024] = pq0; l_[1280] = pq1; l_[1536] = pq2; l_[1792] = pq3; \
    l_[2048] = pk0; l_[2304] = pk1; l_[2560] = pk2; l_[2816] = pk3; l_[3072] = pa0; l_[3328] = pa1; } while (0)
  __syncthreads();
  B2_LOAD(n_begin);
  B2_LOADU(n_begin);
  B2_STORE();
  __syncthreads();
#pragma unroll 1
  for (int n = n_begin; n < n_end; ++n) {
    B2_LOAD(n + 1 < 32 ? n + 1 : n);
    f32x16 vn[2], o[2];
#pragma unroll
    for (int it = 0; it < 2; ++it) {
      f32x16 aw;
#pragma unroll
      for (int e = 0; e < 16; ++e) aw[e] = 0.f;
#pragma unroll
      for (int T = 0; T < 4; ++T)
#pragma unroll
        for (int s = 0; s < 2; ++s) aw = MFMA32(ld16(wg + (it * 4096 + (T * 2 + s) * 512) + lo8), pack8(S[T], s), aw);
#pragma unroll
      for (int g = 0; g < 4; ++g) {
        const uint2 uu = it == 0 ? (g == 0 ? pu0 : g == 1 ? pu1 : g == 2 ? pu2 : pu3) : (g == 0 ? pu4 : g == 1 ? pu5 : g == 2 ? pu6 : pu7);
        vn[it][4 * g + 0] = __uint_as_float(uu.x << 16) - aw[4 * g + 0];
        vn[it][4 * g + 1] = __uint_as_float(uu.x & 0xffff0000u) - aw[4 * g + 1];
        vn[it][4 * g + 2] = __uint_as_float(uu.y << 16) - aw[4 * g + 2];
        vn[it][4 * g + 3] = __uint_as_float(uu.y & 0xffff0000u) - aw[4 * g + 3];
      }
    }
    B2_LOADU(n + 1 < 32 ? n + 1 : n);
    bf16x8 Vb[2][2];
#pragma unroll
    for (int jt = 0; jt < 2; ++jt) { Vb[jt][0] = pack8(vn[jt], 0); Vb[jt][1] = pack8(vn[jt], 1); }
#pragma unroll
    for (int it = 0; it < 2; ++it) {
#pragma unroll
      for (int e = 0; e < 16; ++e) o[it][e] = 0.f;
#pragma unroll
      for (int T = 0; T < 4; ++T)
#pragma unroll
        for (int s = 0; s < 2; ++s) o[it] = MFMA32(ld16(qg + (it * 4096 + (T * 2 + s) * 512) + lo8), pack8(S[T], s), o[it]);
#pragma unroll
      for (int jt = 0; jt < 2; ++jt)
#pragma unroll
        for (int s = 0; s < 2; ++s)
          o[it] = MFMA32(ld16(ag + (it * 2048 + (jt * 2 + s) * 512) + lo8), Vb[jt][s], o[it]);
    }
    const float egl = __shfl(eglv, n);
#pragma unroll
    for (int T = 0; T < 4; ++T) {
      f32x16 acc;
#pragma unroll
      for (int e = 0; e < 16; ++e) acc[e] = S[T][e] * egl;
#pragma unroll
      for (int jt = 0; jt < 2; ++jt)
#pragma unroll
        for (int s = 0; s < 2; ++s)
          acc = MFMA32(ld16(kg + (T * 2048 + (jt * 2 + s) * 512) + lo8), Vb[jt][s], acc);
      S[T] = acc;
    }
    asm volatile("s_waitcnt lgkmcnt(0)\n\ts_barrier" ::: "memory");
    B2_STORE();
    asm volatile("s_waitcnt lgkmcnt(0)\n\ts_barrier" ::: "memory");
    {
      bf16_t* og = p.ob + (size_t)(b * SEQ + n * 64) * 512 + hd * 128 + v0 + r;
#pragma unroll
      for (int it = 0; it < 2; ++it)
#pragma unroll
        for (int e = 0; e < 16; ++e) og[(size_t)(it * 32 + crow(e, hh)) * 512] = f2bf(o[it][e]);
    }
  }
  if (n_end < 32) {
#pragma unroll
    for (int T = 0; T < 4; ++T)
#pragma unroll
      for (int q4 = 0; q4 < 4; ++q4)
        *(float4*)(sst + T * 16 + q4 * 4) = make_float4(S[T][q4 * 4], S[T][q4 * 4 + 1], S[T][q4 * 4 + 2], S[T][q4 * 4 + 3]);
  }
  __syncthreads();
#undef B2_LOAD
#undef B2_LOADU
#undef B2_STORE
}

DI void setup_lut(const Params& p, float* lut) {
#pragma unroll
  for (int q = 0; q < 4; ++q) {
    const int idx = TIDX + 256 * q;
    const int hd = idx >> 7, d = idx & 127;
    int bk;
    if (d < 16) bk = d;
    else {
      const float lr2 = logf((float)d / 16.f) / 2.0794415416798357f;
      bk = 16 + (int)(lr2 * 16.f);
      bk = bk < 31 ? bk : 31;
    }
    lut[idx] = p.rel_bias[bk * 8 + hd] * 1.4426950408889634f;
  }
  __syncthreads();
}

template <int MODE>
DI void attn_branch(f32x16 (&oacc)[2], float& m_run, float& l_run, const bf16x8 (&qf)[4],
                    const bf16_t* __restrict__ Kb, const bf16_t* __restrict__ Vt,
                    int kt_begin, int kt_end, int t, const float* lut, const unsigned* maskrow, unsigned selm) {
  const int lane = TIDX & 63, r = lane & 31, hh = lane >> 5;
  unsigned orm = 0xffffffffu;
  if (MODE == 1) {
    orm = selm;
#pragma unroll
    for (int o = 32; o >= 1; o >>= 1) orm |= __shfl_xor(orm, o);
    orm = __builtin_amdgcn_readfirstlane(orm);
  }
  int kt = kt_begin;
  if (MODE == 1) { while (kt < kt_end && !((orm >> (kt >> 1)) & 1u)) ++kt; }
  if (kt >= kt_end) return;
  const bf16_t* kp = Kb + (hh * 32 + r) * 8;
  const bf16_t* vp = Vt + (hh * 32 + r) * 8;
  unsigned n_mb = 0xffffffffu, c_mb = 0xffffffffu;
#define A_LOAD(P, KT) do { const size_t k0_ = (size_t)(KT) * 2048; const bf16_t* kq_ = kp + k0_; const bf16_t* vq_ = vp + k0_; \
    P##k0 = ld16(kq_); P##k1 = ld16(kq_ + 512); P##k2 = ld16(kq_ + 1024); P##k3 = ld16(kq_ + 1536); \
    P##v00 = ld16(vq_); P##v01 = ld16(vq_ + 512); P##v10 = ld16(vq_ + 1024); P##v11 = ld16(vq_ + 1536); \
    if (MODE == 0) P##mb = maskrow[KT]; } while (0)
  bf16x8 c_k0, c_k1, c_k2, c_k3, c_v00, c_v01, c_v10, c_v11;
  bf16x8 n_k0, n_k1, n_k2, n_k3, n_v00, n_v01, n_v10, n_v11;
  A_LOAD(c_, kt);
#pragma unroll 1
  while (kt < kt_end) {
    int kn = kt + 1;
    if (MODE == 1) { while (kn < kt_end && !((orm >> (kn >> 1)) & 1u)) ++kn; }
    const int kl = kn < kt_end ? kn : kt;
    A_LOAD(n_, kl);
    const int key0 = kt * 32;
    unsigned mb = c_mb;
    if (MODE == 1) mb = ((selm >> (key0 >> 6)) & 1u) ? 0xffffffffu : 0u;
    f32x16 s;
#pragma unroll
    for (int e = 0; e < 16; ++e) s[e] = 0.f;
    s = MFMA32(c_k0, qf[0], s); s = MFMA32(c_k1, qf[1], s); s = MFMA32(c_k2, qf[2], s); s = MFMA32(c_k3, qf[3], s);
    float tmax = -1e30f;
    f32x16 pv;
    const int q0u = __builtin_amdgcn_readfirstlane(t - r);
    const bool far = (MODE != 3) && (q0u - (key0 + 31) >= 127);
    if (far) {
      const float b127 = lut[127];
      const unsigned mbs = mb >> (4 * hh);
      const int dbase = t - key0 - 4 * hh;
#pragma unroll
      for (int e = 0; e < 16; ++e) {
        const int ce = (e & 3) + 8 * (e >> 2);
        bool ok;
        if (MODE == 0) ok = (mbs & (1u << ce)) != 0u;
        else if (MODE == 1) ok = mb != 0u;
        else ok = (dbase - ce) < 512;
        const float lg = __builtin_fmaf(s[e], 0.18033688011112042f, b127);
        pv[e] = ok ? lg : -1e30f;
        tmax = fmaxf(tmax, pv[e]);
      }
    } else {
#pragma unroll
      for (int e = 0; e < 16; ++e) {
        const int kk = crow(e, hh), kidx = key0 + kk;
        const int pos = MODE == 3 ? 16 * kidx + 31 : kidx;
        const int dist = t - pos;
        bool ok = dist >= 0 && ((mb >> kk) & 1u);
        if (MODE == 2) ok = ok && dist < 512;
        if (MODE == 3) ok = ok && kidx < 127;
        int di = dist < 0 ? 0 : (dist > 127 ? 127 : dist);
        const float lg = __builtin_fmaf(s[e], 0.18033688011112042f, lut[di]);
        pv[e] = ok ? lg : -1e30f;
        tmax = fmaxf(tmax, pv[e]);
      }
    }
    tmax = fmaxf(tmax, __shfl_xor(tmax, 32));
    const float m_new = fmaxf(m_run, tmax);
    if (__ballot(m_new != m_run) != 0ull) {
      const float alpha = __builtin_amdgcn_exp2f(m_run - m_new);
      l_run *= alpha; m_run = m_new;
#pragma unroll
      for (int e = 0; e < 16; ++e) { oacc[0][e] *= alpha; oacc[1][e] *= alpha; }
    }
    const float m_use = fmaxf(m_run, -1e29f);
    float psum = 0.f;
#pragma unroll
    for (int e = 0; e < 16; ++e) {
      const float ev = __builtin_amdgcn_exp2f(pv[e] - m_use);
      pv[e] = ev; psum += ev;
    }
    l_run += psum;
    const bf16x8 pf0 = pack8(pv, 0), pf1 = pack8(pv, 1);
    oacc[0] = MFMA32(c_v00, pf0, oacc[0]); oacc[0] = MFMA32(c_v01, pf1, oacc[0]);
    oacc[1] = MFMA32(c_v10, pf0, oacc[1]); oacc[1] = MFMA32(c_v11, pf1, oacc[1]);
    c_mb = n_mb; c_k0 = n_k0; c_k1 = n_k1; c_k2 = n_k2; c_k3 = n_k3; c_v00 = n_v00; c_v01 = n_v01; c_v10 = n_v10; c_v11 = n_v11;
    kt = kn;
  }
#undef A_LOAD
}

DI void store_y(const f32x16 (&o)[2], bf16_t* yrow) {
  const int lane = TIDX & 63, hh = lane >> 5;
#pragma unroll
  for (int dt = 0; dt < 2; ++dt)
#pragma unroll
    for (int g = 0; g < 4; ++g) {
      bf16_t* ptr = yrow + dt * 32 + 8 * g + 4 * hh;
      const uint2 z = *(const uint2*)ptr;
      uint2 w;
      w.x = pack2(o[dt][4 * g + 0] * __uint_as_float(z.x << 16), o[dt][4 * g + 1] * __uint_as_float(z.x & 0xffff0000u));
      w.y = pack2(o[dt][4 * g + 2] * __uint_as_float(z.y << 16), o[dt][4 * g + 3] * __uint_as_float(z.y & 0xffff0000u));
      *(uint2*)ptr = w;
    }
}

DI int wave_sum6(unsigned c) {
  int v = (int)c;
  v += __builtin_amdgcn_update_dpp(0, v, 0x111, 0xf, 0xf, false);
  v += __builtin_amdgcn_update_dpp(0, v, 0x112, 0xf, 0xf, false);
  v += __builtin_amdgcn_update_dpp(0, v, 0x114, 0xf, 0xf, false);
  v += __builtin_amdgcn_update_dpp(0, v, 0x118, 0xf, 0xf, false);
  v += __builtin_amdgcn_update_dpp(0, v, 0x142, 0xa, 0xf, false);
  v += __builtin_amdgcn_update_dpp(0, v, 0x143, 0xc, 0xf, false);
  return __builtin_amdgcn_readlane(v, 63);
}
DI void a1_select(const Params& p, const float* scrow, int t, size_t tokrow, int lane) {
  unsigned long long myword = 0ull;
  if (t >= 256) {
    unsigned a[32];
    unsigned valid = 0u;
#pragma unroll
    for (int i = 0; i < 32; ++i) {
      const int key = i * 64 + lane;
      const unsigned bits = __float_as_uint(scrow[key]);
      a[i] = (bits & 0x80000000u) ? ~bits : (bits | 0x80000000u);
      valid |= (key <= t ? 1u : 0u) << i;
    }
#pragma unroll
    for (int st = 0; st < 5; ++st) {
      const int j = 16 >> st;
      const unsigned m = st == 0 ? 0x0000FFFFu : st == 1 ? 0x00FF00FFu : st == 2 ? 0x0F0F0F0Fu : st == 3 ? 0x33333333u : 0x55555555u;
#pragma unroll
      for (int k = 0; k < 32; ++k) {
        if ((k & j) == 0) {
          const unsigned tt = ((a[k] >> j) ^ a[k + j]) & m;
          a[k + j] ^= tt;
          a[k] ^= tt << j;
        }
      }
    }
    unsigned active = valid, above = 0u;
    int need = 256;
    bool done = false;
#pragma unroll
    for (int pb = 31; pb >= 0; --pb) {
      if (!done) {
        const unsigned m1 = active & a[pb];
        const int c1 = wave_sum6(__popc(m1));
        if (c1 >= need) { active = m1; done = (c1 == need); }
        else { need -= c1; above |= m1; active &= ~a[pb]; }
      }
    }
    int run = 0;
    const unsigned long long lowmask = (1ull << lane) - 1ull;
    const int nties = wave_sum6(__popc(active));
    if (nties == need) {
      const unsigned selb = above | active;
#pragma unroll
      for (int i = 0; i < 32; ++i) {
        const unsigned long long sb = __ballot((selb >> i) & 1u);
        if (lane == i) myword = sb;
      }
    } else
#pragma unroll
    for (int i = 0; i < 32; ++i) {
      const bool tie = (active >> i) & 1u;
      const unsigned long long tb = __ballot(tie);
      const int pre = __popcll(tb & lowmask);
      const bool sel = ((above >> i) & 1u) || (tie && (run + pre) < need);
      run += __popcll(tb);
      const unsigned long long sb = __ballot(sel);
      if (lane == i) myword = sb;
    }
  } else {
#pragma unroll
    for (int i = 0; i < 32; ++i) {
      const unsigned long long sb = __ballot(i * 64 + lane <= t);
      if (lane == i) myword = sb;
    }
  }
  if (lane < 32) ((unsigned long long*)p.bm)[tokrow * 32 + lane] = myword;
}

DI void phaseA1(const Params& p, int vblock, int nvblocks, int ubegin, int uend, char* smem) {
  float* sc = (float*)smem;
  const int tid = TIDX, lane = tid & 63, wid = tid >> 6, r = lane & 31, hh = lane >> 5;
#pragma unroll 1
  for (int u0 = ubegin + vblock; u0 < uend; u0 += nvblocks) {
    const int u = 4095 - u0;
    const int b = u >> 8, q0 = (u & 255) * 8;
    const size_t tokb = (size_t)b * SEQ;
    const int qa = ((r >> 2) & 1) * 2 + (r >> 4), ha = (r & 3) + 4 * ((r >> 3) & 1);
    bf16x8 af0[4], af1[4];
#pragma unroll
    for (int ks = 0; ks < 4; ++ks) {
      af0[ks] = ld16(p.projA + (tokb + q0 + qa) * LDA_A + 640 + ha * 64 + ks * 16 + hh * 8);
      af1[ks] = ld16(p.projA + (tokb + q0 + 4 + qa) * LDA_A + 640 + ha * 64 + ks * 16 + hh * 8);
    }
    float wr0[16], wr1[16];
    {
      const float4* sp = (const float4*)(p.small + (tokb + q0 + hh * 2) * 32);
      const float4 wa = sp[0], wb = sp[1], wc = sp[8], wd = sp[9], we = sp[32], wf = sp[33], wg = sp[40], wh = sp[41];
      __builtin_amdgcn_sched_barrier(0);
      const float cs = 0.044194173824159216f;
      wr0[0] = wa.x * cs; wr0[1] = wa.y * cs; wr0[2] = wa.z * cs; wr0[3] = wa.w * cs; wr0[4] = wb.x * cs; wr0[5] = wb.y * cs; wr0[6] = wb.z * cs; wr0[7] = wb.w * cs;
      wr0[8] = wc.x * cs; wr0[9] = wc.y * cs; wr0[10] = wc.z * cs; wr0[11] = wc.w * cs; wr0[12] = wd.x * cs; wr0[13] = wd.y * cs; wr0[14] = wd.z * cs; wr0[15] = wd.w * cs;
      wr1[0] = we.x * cs; wr1[1] = we.y * cs; wr1[2] = we.z * cs; wr1[3] = we.w * cs; wr1[4] = wf.x * cs; wr1[5] = wf.y * cs; wr1[6] = wf.z * cs; wr1[7] = wf.w * cs;
      wr1[8] = wg.x * cs; wr1[9] = wg.y * cs; wr1[10] = wg.z * cs; wr1[11] = wg.w * cs; wr1[12] = wh.x * cs; wr1[13] = wh.y * cs; wr1[14] = wh.z * cs; wr1[15] = wh.w * cs;
    }
    const int nt = (q0 + 7) / 32 + 1;
    const bf16_t* kib = p.kidxF + (size_t)b * 64 * 2048 + (hh * 32 + r) * 8;
#pragma unroll 1
    for (int kb = wid; kb < nt; kb += 16) {
      bf16x8 kf[4][4];
#pragma unroll
      for (int j = 0; j < 4; ++j) {
        const int kt = kb + 4 * j < nt ? kb + 4 * j : kb;
        const bf16_t* q_ = kib + (size_t)kt * 2048;
        kf[j][0] = ld16(q_); kf[j][1] = ld16(q_ + 512); kf[j][2] = ld16(q_ + 1024); kf[j][3] = ld16(q_ + 1536);
      }
#pragma unroll
      for (int j = 0; j < 4; ++j) {
        const int kt = kb + 4 * j;
        if (kt < nt) {
          f32x16 s0, s1;
#pragma unroll
          for (int e = 0; e < 16; ++e) { s0[e] = 0.f; s1[e] = 0.f; }
#pragma unroll
          for (int ks = 0; ks < 4; ++ks) { s0 = MFMA32(af0[ks], kf[j][ks], s0); s1 = MFMA32(af1[ks], kf[j][ks], s1); }
          float a0 = 0.f, a1 = 0.f, a2 = 0.f, a3 = 0.f;
#pragma unroll
          for (int e = 0; e < 8; ++e) {
            a0 += wr0[e] * fmaxf(s0[e], 0.f); a1 += wr0[8 + e] * fmaxf(s0[8 + e], 0.f);
            a2 += wr1[e] * fmaxf(s1[e], 0.f); a3 += wr1[8 + e] * fmaxf(s1[8 + e], 0.f);
          }
          const int key = kt * 32 + r;
          sc[(hh * 2 + 0) * 2048 + key] = a0 + 0.0f;
          sc[(hh * 2 + 1) * 2048 + key] = a1 + 0.0f;
          sc[(4 + hh * 2 + 0) * 2048 + key] = a2 + 0.0f;
          sc[(4 + hh * 2 + 1) * 2048 + key] = a3 + 0.0f;
        }
      }
    }
    __syncthreads();
    a1_select(p, sc + wid * 2048, q0 + wid, tokb + q0 + wid, lane);
    a1_select(p, sc + (4 + wid) * 2048, q0 + 4 + wid, tokb + q0 + 4 + wid, lane);
    __syncthreads();
  }
}

DI void phaseA2(const Params& p, const float* lut, bool dry) {
  const int lane = TIDX & 63, wid = TIDX >> 6, r = lane & 31, hh = lane >> 5;
#pragma unroll 1
  for (int u = blockIdx.x * 4 + wid; u < 4096; u += gridDim.x * 4) {
    const int itp = (u >> 11) & 1, kq = (u >> 6) & 31;
    const int qb = kq < 16 ? (itp ? 32 + kq : 63 - kq) : (itp ? kq - 16 : 47 - kq), b = (u >> 2) & 15, hd = u & 3;
    const int t = qb * 32 + r;
    const size_t tok = (size_t)b * SEQ + t;
    bf16x8 qf[4];
#pragma unroll
    for (int ks = 0; ks < 4; ++ks) qf[ks] = ld16(p.projA + tok * LDA_A + hd * 64 + ks * 16 + hh * 8);
    f32x16 oacc[2];
#pragma unroll
    for (int e = 0; e < 16; ++e) { oacc[0][e] = 0.f; oacc[1][e] = 0.f; }
    float m_run = -1e30f, l_run = 0.f;
    attn_branch<0>(oacc, m_run, l_run, qf, p.akv + ((size_t)b * 4 + hd) * 64 * 2048,
                   p.avT + ((size_t)b * 4 + hd) * 64 * 2048, 0, qb + 1, t, lut + hd * 128, p.bm + tok * 64, 0u);
    const float lt = l_run + __shfl_xor(l_run, 32);
    const float inv = lt > 0.f ? 1.f / lt : 0.f;
#pragma unroll
    for (int e = 0; e < 16; ++e) { oacc[0][e] *= inv; oacc[1][e] *= inv; }
    if (!dry) store_y(oacc, p.projZ + tok * LDA_Z + hd * 64);
  }
}

DI void phaseC2a(const Params& p, float* lut) {
  const int lane = TIDX & 63, wid = TIDX >> 6, r = lane & 31, hh = lane >> 5;
  const int ubk = (int)blockIdx.x - (int)(gridDim.x >> 1);
#pragma unroll 1
  for (int u = ubk * 4 + wid; ubk >= 0 && u < 1024; u += (gridDim.x >> 1) * 4) {
    const int b = u >> 6, qb = u & 63;
    const int t = qb * 32 + r;
    const size_t tok = (size_t)b * SEQ + t;
    float mainv[16], e3[16];
#pragma unroll
    for (int i = 0; i < 16; ++i) { mainv[i] = 0.f; e3[i] = 0.f; }
    bf16_t* kcs = (bf16_t*)(lut + 1024 + 4 * 32 * 33);
    __syncthreads();
    {
      const uint4* src_ = (const uint4*)(p.kc + (size_t)b * 4 * 2048) + TIDX;
      const uint4 t0 = src_[0], t1 = src_[256], t2 = src_[512], t3 = src_[768];
      uint4* d_ = (uint4*)kcs + TIDX;
      d_[0] = t0; d_[256] = t1; d_[512] = t2; d_[768] = t3;
    }
    __syncthreads();
    const bf16_t* kcb = kcs + (hh * 32 + r) * 8;
#pragma unroll 1
    for (int hd = 0; hd < 4; ++hd) {
      bf16x8 qf[4];
#pragma unroll
      for (int ks = 0; ks < 4; ++ks) qf[ks] = ld16(p.projA + tok * LDA_A + 256 + hd * 64 + ks * 16 + hh * 8);
      float mx = -1e30f, sum = 0.f;
#pragma unroll 1
      for (int pass = 0; pass < 2; ++pass) {
#pragma unroll 1
        for (int tile = 0; tile < 4; ++tile) {
          f32x16 s;
#pragma unroll
          for (int e = 0; e < 16; ++e) s[e] = 0.f;
#pragma unroll
          for (int ks = 0; ks < 4; ++ks) s = MFMA32(ld16(kcb + tile * 2048 + ks * 512), qf[ks], s);
          int tt0 = t; asm volatile("" : "+v"(tt0));
#pragma unroll
          for (int e = 0; e < 16; ++e) {
            const int nn = tile * 32 + crow(e, hh);
            const int dist = tt0 - (16 * nn + 31);
            const bool ok = dist >= 0 && nn < 127;
            const int di = dist < 0 ? 0 : (dist > 127 ? 127 : dist);
            const float lg = __builtin_fmaf(s[e], 0.18033688011112042f, lut[(4 + hd) * 128 + di]);
            if (pass == 0) mx = fmaxf(mx, ok ? lg : -1e30f);
            else sum += ok ? __builtin_amdgcn_exp2f(lg - mx) : 0.f;
          }
        }
        if (pass == 0) mx = fmaxf(mx, __shfl_xor(mx, 32));
      }
      sum += __shfl_xor(sum, 32);
      const float inv = sum > 0.f ? 1.f / sum : 0.f;
#pragma unroll
      for (int tile = 0; tile < 4; ++tile) {
        f32x16 s;
#pragma unroll
        for (int e = 0; e < 16; ++e) s[e] = 0.f;
#pragma unroll
        for (int ks = 0; ks < 4; ++ks) s = MFMA32(ld16(kcb + tile * 2048 + ks * 512), qf[ks], s);
        int tt = t; asm volatile("" : "+v"(tt));
#pragma unroll
        for (int e = 0; e < 16; ++e) {
          const int nn = tile * 32 + crow(e, hh);
          const int dist = tt - (16 * nn + 31);
          const bool ok = dist >= 0 && nn < 127;
          const int di = dist < 0 ? 0 : (dist > 127 ? 127 : dist);
          const float lg = __builtin_fmaf(s[e], 0.18033688011112042f, lut[(4 + hd) * 128 + di]);
          s[e] = ok ? __builtin_amdgcn_exp2f(lg - mx) * inv : 0.f;
        }
#pragma unroll
        for (int g = 0; g < 4; ++g) {
          const float a3 = s[4 * g + 3];
          mainv[tile * 4 + g] += s[4 * g] + s[4 * g + 1] + s[4 * g + 2] + a3;
          e3[tile * 4 + g] += a3;
        }
      }
    }
    float recv[16], imp[16];
#pragma unroll
    for (int i = 0; i < 16; ++i) recv[i] = __shfl_xor(e3[i], 32);
#pragma unroll
    for (int i = 0; i < 16; ++i) {
      const float prev = i > 0 ? recv[i - 1] : 0.f;
      imp[i] = mainv[i] + (hh ? recv[i] : prev);
    }
    const int cur = t >> 6;
    const int curm1 = cur > 0 ? cur - 1 : 0;
#pragma unroll
    for (int i = 0; i < 16; ++i) {
      const int j = 2 * i + hh;
      const bool adm = j <= cur, forced = (j == 0) || (j == cur) || (j == curm1);
      imp[i] = adm ? (forced ? 1e9f : imp[i]) : -1e30f;
    }
    float* vals = (float*)lut + 1024 + (wid * 32 + r) * 33;
    asm volatile("s_waitcnt lgkmcnt(0)" ::: "memory");
#pragma unroll
    for (int i = 0; i < 16; ++i) vals[2 * i + hh] = imp[i];
    asm volatile("s_waitcnt lgkmcnt(0)" ::: "memory");
    unsigned own = 0u;
#pragma unroll 1
    for (int i = 0; i < 16; ++i) {
      const int j = 2 * i + hh;
      const float v = vals[j];
      int rank = 0;
#pragma unroll 8
      for (int k = 0; k < 32; ++k) {
        const float o = vals[k];
        rank += (o > v || (o == v && k < j)) ? 1 : 0;
      }
      if (rank < 16 && j <= cur) own |= 1u << j;
    }
    asm volatile("s_waitcnt lgkmcnt(0)" ::: "memory");
    own |= __shfl_xor(own, 32);
    if (hh == 0) p.selmask[tok] = own;
  }
}

DI void phaseC2b(const Params& p, const float* lut, bool dry) {
  const int lane = TIDX & 63, wid = TIDX >> 6, r = lane & 31, hh = lane >> 5;
#pragma unroll 1
  for (int u = blockIdx.x * 4 + wid; u < 4096; u += gridDim.x * 4) {
    const int itp = (u >> 11) & 1, kq = (u >> 6) & 31;
    const int qb = itp ? kq : 63 - kq, b = (u >> 2) & 15, hd = u & 3;
    const int t = qb * 32 + r;
    const size_t tok = (size_t)b * SEQ + t;
    bf16x8 qf[4];
#pragma unroll
    for (int ks = 0; ks < 4; ++ks) qf[ks] = ld16(p.projA + tok * LDA_A + 256 + hd * 64 + ks * 16 + hh * 8);
    const float* lh = lut + (4 + hd) * 128;
    const unsigned selm = p.selmask[tok];
    const float gt0 = p.small[tok * 32 + 16 + hd * 3], gt1 = p.small[tok * 32 + 17 + hd * 3], gt2 = p.small[tok * 32 + 18 + hd * 3];
    f32x16 tot[2];
#pragma unroll
    for (int e = 0; e < 16; ++e) { tot[0][e] = 0.f; tot[1][e] = 0.f; }
#pragma unroll 1
    for (int br = 0; br < 3; ++br) {
      f32x16 oacc[2];
#pragma unroll
      for (int e = 0; e < 16; ++e) { oacc[0][e] = 0.f; oacc[1][e] = 0.f; }
      float m_run = -1e30f, l_run = 0.f;
      if (br == 0)
        attn_branch<3>(oacc, m_run, l_run, qf, p.kc + (size_t)b * 4 * 2048, p.vcT + (size_t)b * 4 * 2048, 0, 4, t, lh, nullptr, 0u);
      else if (br == 1)
        attn_branch<1>(oacc, m_run, l_run, qf, p.kselF + (size_t)b * 64 * 2048, p.vselT + (size_t)b * 64 * 2048, 0, qb + 1, t, lh, nullptr, selm);
      else {
        const int kb = qb - 16 > 0 ? qb - 16 : 0;
        attn_branch<2>(oacc, m_run, l_run, qf, p.kwinF + (size_t)b * 64 * 2048, p.vwinT + (size_t)b * 64 * 2048, kb, qb + 1, t, lh, nullptr, 0u);
      }
      const float lt = l_run + __shfl_xor(l_run, 32);
      const float gate = sigmoidf(br == 0 ? gt0 : (br == 1 ? gt1 : gt2));
      const float sc = lt > 0.f ? gate / lt : 0.f;
#pragma unroll
      for (int e = 0; e < 16; ++e) { tot[0][e] += oacc[0][e] * sc; tot[1][e] += oacc[1][e] * sc; }
    }
    if (!dry) store_y(tot, p.projZ + tok * LDA_Z + 768 + hd * 64);
  }
}

DI void phaseB3(const Params& p, int l) {
  const int lane = TIDX & 63, wid = TIDX >> 6;
  const float* g = p.b_out_norm + l * 128;
  const int d0 = (lane & 15) * 8;
  float gq[8];
#pragma unroll
  for (int i = 0; i < 8; ++i) gq[i] = g[d0 + i];
  const int tstep = gridDim.x * 4;
  int t = blockIdx.x * 4 + wid;
  uint4 nov = make_uint4(0, 0, 0, 0), nzv = make_uint4(0, 0, 0, 0);
  if (t < T_TOK) { nov = *(const uint4*)(p.ob + (size_t)t * 512 + lane * 8); nzv = *(const uint4*)(p.projZ + (size_t)t * LDA_Z + 256 + lane * 8); }
#pragma unroll 1
  for (; t < T_TOK; t += tstep) {
    const uint4 ov = nov, zv = nzv;
    const int tn = t + tstep < T_TOK ? t + tstep : t;
    nov = *(const uint4*)(p.ob + (size_t)tn * 512 + lane * 8); nzv = *(const uint4*)(p.projZ + (size_t)tn * LDA_Z + 256 + lane * 8);
    float v[8], z[8];
    v[0] = __uint_as_float(ov.x << 16); v[1] = __uint_as_float(ov.x & 0xffff0000u);
    v[2] = __uint_as_float(ov.y << 16); v[3] = __uint_as_float(ov.y & 0xffff0000u);
    v[4] = __uint_as_float(ov.z << 16); v[5] = __uint_as_float(ov.z & 0xffff0000u);
    v[6] = __uint_as_float(ov.w << 16); v[7] = __uint_as_float(ov.w & 0xffff0000u);
    z[0] = __uint_as_float(zv.x << 16); z[1] = __uint_as_float(zv.x & 0xffff0000u);
    z[2] = __uint_as_float(zv.y << 16); z[3] = __uint_as_float(zv.y & 0xffff0000u);
    z[4] = __uint_as_float(zv.z << 16); z[5] = __uint_as_float(zv.z & 0xffff0000u);
    z[6] = __uint_as_float(zv.w << 16); z[7] = __uint_as_float(zv.w & 0xffff0000u);
    float ss = 0.f;
#pragma unroll
    for (int i = 0; i < 8; ++i) ss += v[i] * v[i];
#pragma unroll
    for (int o = 8; o >= 1; o >>= 1) ss += __shfl_xor(ss, o);
    const float rr = rsqrtf(ss * (1.f / 128.f) + 1e-6f);
    float y[8];
#pragma unroll
    for (int i = 0; i < 8; ++i) y[i] = v[i] * rr * gq[i] * z[i];
    uint4 w; w.x = pack2(y[0], y[1]); w.y = pack2(y[2], y[3]); w.z = pack2(y[4], y[5]); w.w = pack2(y[6], y[7]);
    *(uint4*)(p.projZ + (size_t)t * LDA_Z + 256 + lane * 8) = w;
  }
}

DI void kvup_tile(const Params& p, int l, int mt, int tn, char* smem) {
  f32x16 acc[2][2];
  const int m0 = mt * 128;
  gemm_main<2>(acc, p.projA + 512, RowLin{LDA_A}, 64, m0, T_TOK, p.wt_ukv, 128, tn * 128, 2, smem);
  float* Ct = (float*)smem; float* rn = (float*)(smem + 128 * 132 * 4);
  acc_to_ct<2>(acc, Ct);
  const int b = m0 / SEQ, s0 = m0 % SEQ;
  if (tn < 2) {
    epi_rownorm(Ct, rn, 64);
    const float* g = p.a_k_norm + l * 64;
    epi_storeKF(Ct, 0, rn, 0, g, p.akv + (((size_t)b * 4 + tn * 2) * 64 + s0 / 32) * 2048);
    epi_storeKF(Ct, 64, rn, 1, g, p.akv + (((size_t)b * 4 + tn * 2 + 1) * 64 + s0 / 32) * 2048);
  } else {
    const int h0 = (tn - 2) * 2;
    epi_storeVF(Ct, 0, p.avT + (((size_t)b * 4 + h0) * 64 + s0 / 32) * 2048);
    epi_storeVF(Ct, 64, p.avT + (((size_t)b * 4 + h0 + 1) * 64 + s0 / 32) * 2048);
  }
  __syncthreads();
}

DI void cmp1_tile(const Params& p, int kv, int mt, int tn, char* smem) {
  f32x16 acc[2][2];
  const int m0 = mt * 128;
  gemm_main<2>(acc, p.projA, RowCmp{(size_t)(kv ? 1280 : 1216)}, LDA_A, m0, 2032, p.wt_phi1 + (size_t)kv * 256 * 2048, 2048, tn * 128, 32, smem);
  float* Ct = (float*)smem;
  acc_to_ct<2>(acc, Ct);
  bf16_t* dst = p.hid + (size_t)kv * 2048 * 256;
  epi_store64(Ct, 0, nullptr, 0, nullptr, true, p.posbias + kv * 256 + tn * 128, dst, 256, tn * 128, m0, 2032);
  epi_store64(Ct, 64, nullptr, 0, nullptr, true, p.posbias + kv * 256 + tn * 128 + 64, dst, 256, tn * 128 + 64, m0, 2032);
  __syncthreads();
}

DI void cmp2_tile(const Params& p, int l, int kv, int mt, char* smem) {
  f32x16 acc[2][2];
  const int m0 = mt * 128;
  gemm_main<2>(acc, p.hid + (size_t)kv * 2048 * 256, RowLin{256}, 64, m0, 2032, p.wt_phi2 + (size_t)kv * 128 * 256, 256, 0, 4, smem);
  float* Ct = (float*)smem; float* rn = (float*)(smem + 128 * 132 * 4);
  acc_to_ct<2>(acc, Ct);
  if (kv == 0) {
    epi_rownorm(Ct, rn, 64);
    const float* g = p.c_k_norm + (l * 3 + 0) * 64;
    for (int idx = TIDX; idx < 128 * 64; idx += 256) {
      const int row = idx >> 6, d = idx & 63, m = m0 + row;
      if (m >= 2032) continue;
      const int b = m / 127, n = m % 127;
      p.kc[((size_t)b * 4 + (n >> 5)) * 2048 + foff_nat(n & 31, d)] = f2bf(Ct[row * 132 + d] * rn[row * 2] * g[d]);
      if (n == 126) p.kc[((size_t)b * 4 + 3) * 2048 + foff_nat(31, d)] = 0;
    }
  } else {
    for (int idx = TIDX; idx < 128 * 64; idx += 256) {
      const int d = idx >> 7, row = idx & 127, m = m0 + row;
      if (m >= 2032) continue;
      const int b = m / 127, n = m % 127;
      p.vcT[((size_t)b * 4 + (n >> 5)) * 2048 + (d >> 5) * 1024 + foff_perm(d & 31, n & 31)] = f2bf(Ct[row * 132 + d]);
      if (n == 126) p.vcT[((size_t)b * 4 + 3) * 2048 + (d >> 5) * 1024 + foff_perm(d & 31, 31)] = 0;
    }
  }
  __syncthreads();
}

DI void merge_tile(const Params& p, int mt, int nt, char* smem) {
  f32x16 mac[2][1];
#pragma unroll
  for (int i = 0; i < 2; ++i)
#pragma unroll
    for (int e = 0; e < 16; ++e) mac[i][0][e] = 0.f;
  const int m0 = mt * 128, n0 = nt * 64;
#pragma unroll 1
  for (int x = 0; x < 3; ++x) {
    const int koff = x == 0 ? 0 : (x == 1 ? 256 : 768);
    const int nkp = x == 1 ? 8 : 4;
    f32x16 ag[2][1], ap[2][1];
    gemm_main<1>(ag, p.h, RowLin{1024}, 64, m0, T_TOK, p.wt_in + (size_t)(4224 + x * 1024) * 1024, 1024, n0, 16, smem);
    gemm_main<1>(ap, p.projZ + koff, RowLin{LDA_Z}, 64, m0, T_TOK, p.wt_br + koff, 1024, n0, nkp, smem);
#pragma unroll
    for (int i = 0; i < 2; ++i)
#pragma unroll
      for (int e = 0; e < 16; ++e) mac[i][0][e] += sigmoidf(ag[i][0][e]) * ap[i][0][e];
  }
  float* Ct = (float*)smem;
  acc_to_ct<1>(mac, Ct);
  epi_store64(Ct, 0, nullptr, 0, nullptr, false, nullptr, p.merged, 1024, n0, m0, T_TOK);
  __syncthreads();
}

DI void outproj_tile(const Params& p, int l, int mt, int tn, char* smem) {
  f32x16 acc[2][2];
  const int m0 = mt * 128;
  gemm_main<2>(acc, p.merged, RowLin{1024}, 64, m0, T_TOK, p.wt_out, 1024, tn * 128, 16, smem);
  float* Ct = (float*)smem;
  acc_to_ct<2>(acc, Ct);
  const float* xo = l == 0 ? p.x_in : p.out;
  {
    const int tid = TIDX, c = (tid & 31) * 4, row0 = tid >> 5;
    float4 xa[16];
#pragma unroll
    for (int q = 0; q < 16; ++q) xa[q] = *(const float4*)(xo + (size_t)(m0 + row0 + 8 * q) * 1024 + tn * 128 + c);
#pragma unroll
    for (int q = 0; q < 16; ++q) {
      const float4 cc = *(const float4*)(Ct + (row0 + 8 * q) * 132 + c);
      *(float4*)(p.out + (size_t)(m0 + row0 + 8 * q) * 1024 + tn * 128 + c) = make_float4(xa[q].x + cc.x, xa[q].y + cc.y, xa[q].z + cc.z, xa[q].w + cc.w);
    }
  }
  __syncthreads();
}

__global__ void __launch_bounds__(256, 2) mega(Params p, int ph_lo, int ph_hi) {
  __shared__ __attribute__((aligned(16))) char smem[SMEM_BYTES];
  cg::grid_group grid = cg::this_grid();
  for (int ph = ph_lo; ph < ph_hi; ++ph) {
    const int l = ph / NPH, s = ph % NPH;
    const int reps = ((DUP_MASK >> s) & 1) ? 2 : 1;
    for (int rep = 0; rep < reps; ++rep) {
    if (rep > 0) grid.sync();
    switch (s) {
      case 0: if (PHASE_ONLY >= 0 && PHASE_ONLY != 0) break; phase0(p, l, smem); break;
      case 1: if (PHASE_ONLY >= 0 && PHASE_ONLY != 1) break; phase_inproj(p, l, true, 0, smem); break;
      case 2: if (PHASE_ONLY >= 0 && PHASE_ONLY != 2) break; phaseB1(p, l, smem); break;
      case 3: if (PHASE_ONLY >= 0 && PHASE_ONLY != 3) break; {
        const int nb2 = gridDim.x >= 128 ? 64 : 0;
        if ((int)blockIdx.x < nb2) phaseB2(p, blockIdx.x, smem, 0, B2_S1);
        else phase_inproj(p, l, false, nb2, smem);
        if (nb2 == 0) for (int u = blockIdx.x; u < 64; u += gridDim.x) phaseB2(p, u, smem, 0, B2_S1);
      } break;
      case 4: if (PHASE_ONLY >= 0 && PHASE_ONLY != 4) break; {
        const int nb2 = gridDim.x >= 128 ? 64 : 0;
        if ((int)blockIdx.x < nb2) phaseB2(p, blockIdx.x, smem, B2_S1, B2_S2);
        else {
          for (int t = blockIdx.x - nb2; t < 64 + 1024; t += gridDim.x - nb2) {
            if (t < 64) cmp1_tile(p, t >> 5, (t >> 1) & 15, t & 1, smem);
            else { const int tt = t - 64; kvup_tile(p, l, tt >> 2, tt & 3, smem); }
          }
          const int va = (int)blockIdx.x - nb2 - 64, nva = (int)gridDim.x - nb2 - 64;
          if (nb2 && va >= 0 && nva > 0) phaseA1(p, va, nva, 0, A1_EARLY, smem);
        }
        if (nb2 == 0) for (int u = blockIdx.x; u < 64; u += gridDim.x) phaseB2(p, u, smem, B2_S1, B2_S2);
      } break;
      case 5: if (PHASE_ONLY >= 0 && PHASE_ONLY != 5) break; {
        const int nb2 = gridDim.x >= 128 ? 64 : 0;
        const int nvb = gridDim.x - nb2;
        const int ubeg = (nb2 && (int)gridDim.x - nb2 - 64 > 0) ? A1_EARLY : 0;
        const int usplit = nb2 ? ubeg + (4096 - ubeg - 3 * nb2) / nvb * nvb : 4096;
        if ((int)blockIdx.x < nb2) {
          phaseB2(p, blockIdx.x, smem, B2_S2, 32);
          phaseA1(p, blockIdx.x, nb2, usplit, 4096, smem);
        } else {
          for (int t = blockIdx.x - nb2; t < 32; t += nvb) cmp2_tile(p, l, t >> 4, t & 15, smem);
          phaseA1(p, blockIdx.x - nb2, nvb, ubeg, usplit, smem);
        }
        if (nb2 == 0) for (int u = blockIdx.x; u < 64; u += gridDim.x) phaseB2(p, u, smem, B2_S2, 32);
      } break;
      case 6: if (PHASE_ONLY >= 0 && PHASE_ONLY != 6) break; break;
      case 7: if (PHASE_ONLY >= 0 && PHASE_ONLY != 7) break; {
        float* lut = (float*)smem;
        setup_lut(p, lut);
#ifndef SKIP_C2A
        if (!(rep > 0 && PROBE7 == 2)) phaseC2a(p, lut);
#endif
#ifndef SKIP_A2
        if (!(rep > 0 && PROBE7 == 1)) phaseA2(p, lut, rep > 0);
#endif
        __syncthreads();
      } break;
      case 8: if (PHASE_ONLY >= 0 && PHASE_ONLY != 8) break; {
        float* lut = (float*)smem;
        setup_lut(p, lut);
        phaseC2b(p, lut, rep > 0);
        if (rep == 0) phaseB3(p, l);
        __syncthreads();
      } break;
      case 9: if (PHASE_ONLY >= 0 && PHASE_ONLY != 9) break; {
        for (int idx = blockIdx.x >> 3; idx < 512; idx += gridDim.x >> 3) { const int t = (blockIdx.x & 7) * 512 + idx; merge_tile(p, t >> 4, t & 15, smem); }
      } break;
      case 10: if (PHASE_ONLY >= 0 && PHASE_ONLY != 10) break; {
        for (int idx = blockIdx.x >> 3; idx < 256; idx += gridDim.x >> 3) { const int t = (blockIdx.x & 7) * 256 + idx; outproj_tile(p, l, t >> 3, t & 7, smem); }
      } break;
    }
    }
    if (ph + 1 < ph_hi && s != 5) grid.sync();
  }
}

extern "C" void kernel_launch(void* const* d_in, const int* in_sizes, int n_in, void* d_out, int out_size, void* d_ws,
                              size_t ws_size, hipStream_t stream) {
  Params p{};
  p.x_in = (const float*)d_in[0]; p.norm_g = (const float*)d_in[1]; p.w_in = (const float*)d_in[2];
  p.a_kv_norm = (const float*)d_in[3]; p.a_w_ukv = (const float*)d_in[4]; p.a_q_norm = (const float*)d_in[5];
  p.a_k_norm = (const float*)d_in[6]; p.b_conv = (const float*)d_in[7]; p.b_a_log = (const float*)d_in[8];
  p.b_dt_bias = (const float*)d_in[9]; p.b_out_norm = (const float*)d_in[10]; p.c_q_norm = (const float*)d_in[11];
  p.c_k_norm = (const float*)d_in[12]; p.c_cmp_pos = (const float*)d_in[13]; p.c_phi_w1 = (const float*)d_in[14];
  p.c_phi_w2 = (const float*)d_in[15]; p.w_branch = (const float*)d_in[16]; p.w_out = (const float*)d_in[17];
  p.rel_bias = (const float*)d_in[18];
  p.out = (float*)d_out;
  char* ws = (char*)d_ws; size_t off = 0;
  auto take = [&](size_t bytes) { char* q = ws + off; off += (bytes + 255) & ~(size_t)255; return q; };
  p.wt_in = (bf16_t*)take((size_t)7296 * 1024 * 2);
  p.wt_ukv = (bf16_t*)take((size_t)512 * 128 * 2);
  p.wt_phi1 = (bf16_t*)take((size_t)2 * 256 * 2048 * 2);
  p.wt_phi2 = (bf16_t*)take((size_t)2 * 128 * 256 * 2);
  p.wt_br = (bf16_t*)take((size_t)1024 * 1024 * 2);
  p.wt_out = (bf16_t*)take((size_t)1024 * 1024 * 2);
  p.posbias = (float*)take(2 * 256 * 4);
  p.h = (bf16_t*)take((size_t)T_TOK * 1024 * 2);
  char* X = take((size_t)T_TOK * (LDA_A + LDA_Z) * 2);
  p.projA = (bf16_t*)X; p.projZ = (bf16_t*)(X + (size_t)T_TOK * LDA_A * 2); p.projB = (bf16_t*)X;
  p.small = (float*)take((size_t)T_TOK * 32 * 4);
  p.akv = (bf16_t*)take((size_t)T_TOK * 256 * 2);
  p.avT = (bf16_t*)take((size_t)T_TOK * 256 * 2);
  p.vselT = (bf16_t*)take((size_t)T_TOK * 64 * 2);
  p.vwinT = (bf16_t*)take((size_t)T_TOK * 64 * 2);
  p.kselF = (bf16_t*)take((size_t)T_TOK * 64 * 2);
  p.kwinF = (bf16_t*)take((size_t)T_TOK * 64 * 2);
  p.kidxF = (bf16_t*)take((size_t)T_TOK * 64 * 2);
  p.hid = (bf16_t*)take((size_t)2 * 2048 * 256 * 2);
  p.kc = (bf16_t*)take((size_t)16 * 128 * 64 * 2);
  p.vcT = (bf16_t*)take((size_t)16 * 64 * 128 * 2);
  p.bm = (unsigned*)take((size_t)T_TOK * 64 * 4);
  p.selmask = (unsigned*)take((size_t)T_TOK * 4);
  char* BR = take((size_t)2048 * 8192 * 2 * 4);
  p.b_w = (bf16_t*)BR; p.b_qd = p.b_w + (size_t)2048 * 8192; p.b_kdT = p.b_qd + (size_t)2048 * 8192; p.b_uT = p.b_kdT + (size_t)2048 * 8192;
  p.merged = (bf16_t*)BR;
  p.b_attn = (bf16_t*)take((size_t)2048 * 4096 * 2);
  p.b_egl = (float*)take(2048 * 4);
  p.b_state = (float*)take((size_t)2 * 64 * 256 * 64 * 4);
  p.ob = (bf16_t*)take((size_t)T_TOK * 512 * 2);
  if (off > ws_size) { fprintf(stderr, "workspace too small: need %zu have %zu\n", off, ws_size); return; }

  static int grid_blocks = 0;
  if (!grid_blocks) {
    int dev = 0, cus = 0, per_cu = 0;
    hipGetDevice(&dev);
    hipDeviceGetAttribute(&cus, hipDeviceAttributeMultiprocessorCount, dev);
    hipOccupancyMaxActiveBlocksPerMultiprocessor(&per_cu, mega, 256, 0);
    if (per_cu < 1) per_cu = 1;
    grid_blocks = cus * per_cu;
  }
  int lo = 0, hi = 4 * NPH;
  void* args[] = {&p, &lo, &hi};
  hipError_t e = hipLaunchCooperativeKernel((void*)mega, dim3(grid_blocks), dim3(256), args, 0, stream);
  if (e != hipSuccess) fprintf(stderr, "cooperative launch failed: %s (grid %d)\n", hipGetErrorString(e), grid_blocks);
}
```
